# Optimizing an MI355X kernel written in HIP

```python
import math
import jax, jax.numpy as jnp
from jax import lax
import numpy as np

D_MODEL = 1024
BATCH = 8
SEQ = 4096
DEPTH = 1

N_META = 16
DA_HEADS = 8
DA_HEAD_DIM = 64
DA_VDIM = 2 * DA_HEAD_DIM
DA_WIDTH = DA_HEADS * DA_VDIM
RET_HEADS = 4
RET_QK_DIM = D_MODEL // RET_HEADS
RET_V_DIM = 2 * D_MODEL // RET_HEADS
RET_WIDTH = RET_HEADS * RET_V_DIM
RET_CHUNK = 128
Q_BLOCK = 128
D_FF = 4 * D_MODEL
NORM_EPS = 1e-6

SPLITS = (
    DA_HEADS * 2 * DA_HEAD_DIM,
    DA_HEADS * 2 * DA_HEAD_DIM,
    DA_WIDTH,
    RET_HEADS * RET_QK_DIM,
    RET_HEADS * RET_QK_DIM,
    RET_WIDTH,
    RET_WIDTH,
    D_MODEL,
    D_MODEL,
)
D_IN = sum(SPLITS)
SPLIT_POINTS = tuple(int(c) for c in np.cumsum(SPLITS)[:-1])

kernel_name = "hybrid_diffattn_retention_gated_block"


def rmsnorm(x, g):
    xf = x.astype(jnp.float32)
    y = xf * lax.rsqrt(jnp.mean(xf * xf, axis=-1, keepdims=True) + NORM_EPS)
    return (y * g.astype(jnp.float32)).astype(x.dtype)


def head_rms(x):
    xf = x.astype(jnp.float32)
    return (xf * lax.rsqrt(jnp.mean(xf * xf, axis=-1, keepdims=True) + NORM_EPS)).astype(x.dtype)


def alibi_slopes(n):
    return 2.0 ** (-8.0 * (jnp.arange(n, dtype=jnp.float32) + 1.0) / n)


def lambda_init(layer):
    return 0.8 - 0.6 * math.exp(-0.3 * layer)


def diff_attention(q, k, v, lam, lam_init, head_g):
    B, L = q.shape[0], q.shape[1]
    scale = DA_HEAD_DIM ** -0.5
    slopes = alibi_slopes(DA_HEADS)
    pos = jnp.arange(L, dtype=jnp.int32)

    def attend(qb, qpos, kb, vb, kpos):
        s = jnp.einsum('bqhcd,bkhcd->bhcqk', qb, kb).astype(jnp.float32) * scale
        dist = (qpos[:, None] - kpos[None, :]).astype(jnp.float32)
        s = s - slopes[None, :, None, None, None] * dist
        s = jnp.where(dist >= 0, s, -jnp.inf)
        p = jax.nn.softmax(s, axis=-1)
        a = p[:, :, 0] - lam * p[:, :, 1]
        return jnp.einsum('bhqk,bkhd->bqhd', a.astype(vb.dtype), vb)

    o_meta = attend(q[:, :N_META], pos[:N_META], k[:, :N_META], v[:, :N_META], pos[:N_META])
    n_blk = (L - N_META) // Q_BLOCK
    q_real = q[:, N_META:].reshape(B, n_blk, Q_BLOCK, DA_HEADS, 2, DA_HEAD_DIM)
    q_real = jnp.moveaxis(q_real, 1, 0)

    def block_fn(args):
        qb, i = args
        qpos = N_META + i * Q_BLOCK + jnp.arange(Q_BLOCK, dtype=jnp.int32)
        return attend(qb, qpos, k, v, pos)

    o_real = lax.map(block_fn, (q_real, jnp.arange(n_blk, dtype=jnp.int32)))
    o_real = jnp.moveaxis(o_real, 0, 1).reshape(B, L - N_META, DA_HEADS, DA_VDIM)
    o = jnp.concatenate([o_meta, o_real], axis=1)
    o = rmsnorm(o, head_g) * (1.0 - lam_init)
    return o.reshape(B, L, DA_WIDTH)


def retention(q, k, v):
    B, L = q.shape[0], q.shape[1]
    log_gamma = jnp.log(1.0 - 2.0 ** (-5.0 - jnp.arange(RET_HEADS, dtype=jnp.float32)))
    k = k * (RET_QK_DIM ** -0.5)
    q, k, v = (jnp.transpose(t, (0, 2, 1, 3)) for t in (q, k, v))

    def intra_decay(n):
        i = jnp.arange(n, dtype=jnp.float32)
        diff = i[:, None] - i[None, :]
        dec = jnp.exp(jnp.maximum(diff, 0.0)[None] * log_gamma[:, None, None])
        return jnp.where(diff[None] >= 0, dec, 0.0)

    def end_decay(n):
        return jnp.exp((n - 1 - jnp.arange(n, dtype=jnp.float32))[None] * log_gamma[:, None])

    qm, km, vm = q[:, :, :N_META], k[:, :, :N_META], v[:, :, :N_META]
    o_meta = jnp.einsum('bhqk,bhke->bhqe',
                        jnp.einsum('bhqd,bhkd->bhqk', qm, km) * intra_decay(N_META), vm)
    state0 = jnp.einsum('bhkd,bhke->bhde', km * end_decay(N_META)[None, :, :, None], vm)

    n_chunk = (L - N_META) // RET_CHUNK
    def chunks(t):
        t = t[:, :, N_META:].reshape(B, RET_HEADS, n_chunk, RET_CHUNK, t.shape[-1])
        return jnp.moveaxis(t, 2, 0)

    d_c = intra_decay(RET_CHUNK)
    cross_dec = jnp.exp((jnp.arange(RET_CHUNK, dtype=jnp.float32) + 1.0)[None] * log_gamma[:, None])
    end_dec = end_decay(RET_CHUNK)
    chunk_dec = jnp.exp(RET_CHUNK * log_gamma)

    def step(S, inp):
        qc, kc, vc = inp
        inner = jnp.einsum('bhqk,bhke->bhqe', jnp.einsum('bhqd,bhkd->bhqk', qc, kc) * d_c, vc)
        cross = jnp.einsum('bhqd,bhde->bhqe', qc * cross_dec[None, :, :, None], S)
        S_new = S * chunk_dec[None, :, None, None] + jnp.einsum(
            'bhkd,bhke->bhde', kc * end_dec[None, :, :, None], vc)
        return S_new, inner + cross

    _, o_real = lax.scan(step, state0, (chunks(q), chunks(k), chunks(v)))
    o_real = jnp.moveaxis(o_real, 0, 2).reshape(B, RET_HEADS, L - N_META, RET_V_DIM)
    o = jnp.concatenate([o_meta, o_real], axis=2).astype(v.dtype)
    return jnp.transpose(o, (0, 2, 1, 3))


def setup_inputs(seed: int = 0) -> dict:
    key = jax.random.key(seed)
    ks = jax.random.split(key, 20)
    f = jnp.float32
    nrm = lambda k, shape, s: jax.random.normal(k, shape, f) * s
    return {
        "x": nrm(ks[0], (BATCH, SEQ, D_MODEL), 1.0),
        "meta_tokens": nrm(ks[1], (N_META, D_MODEL), 1.0),
        "norm_mix_g": 1.0 + nrm(ks[2], (DEPTH, D_MODEL), 0.02),
        "w_in": nrm(ks[3], (DEPTH, D_MODEL, D_IN), D_MODEL ** -0.5),
        "da_lambda_q1": nrm(ks[4], (DEPTH, DA_HEAD_DIM), 0.1),
        "da_lambda_k1": nrm(ks[5], (DEPTH, DA_HEAD_DIM), 0.1),
        "da_lambda_q2": nrm(ks[6], (DEPTH, DA_HEAD_DIM), 0.1),
        "da_lambda_k2": nrm(ks[7], (DEPTH, DA_HEAD_DIM), 0.1),
        "da_head_g": 1.0 + nrm(ks[8], (DEPTH, DA_VDIM), 0.02),
        "w_proj_da": nrm(ks[9], (DEPTH, DA_WIDTH, D_MODEL), DA_WIDTH ** -0.5),
        "w_proj_ret": nrm(ks[10], (DEPTH, RET_WIDTH, D_MODEL), RET_WIDTH ** -0.5),
        "w_out": nrm(ks[11], (DEPTH, D_MODEL, D_MODEL), D_MODEL ** -0.5),
        "norm_mlp_g": 1.0 + nrm(ks[12], (DEPTH, D_MODEL), 0.02),
        "w_up": nrm(ks[13], (DEPTH, D_MODEL, D_FF), D_MODEL ** -0.5),
        "w_down": nrm(ks[14], (DEPTH, D_FF, D_MODEL), D_FF ** -0.5),
        "final_norm_g": 1.0 + nrm(ks[15], (D_MODEL,), 0.02),
    }


def reference(x, meta_tokens, norm_mix_g, w_in, da_lambda_q1, da_lambda_k1, da_lambda_q2,
              da_lambda_k2, da_head_g, w_proj_da, w_proj_ret, w_out, norm_mlp_g, w_up,
              w_down, final_norm_g):
    B, S, D = x.shape
    L = S + N_META
    meta = jnp.broadcast_to(meta_tokens[None].astype(x.dtype), (B, N_META, D))
    h = jnp.concatenate([meta, x], axis=1)

    for layer in range(DEPTH):
        u = rmsnorm(h, norm_mix_g[layer])
        proj = u @ w_in[layer]
        qa, ka, va, qr, kr, vr, gr_out, g_a, g_r = jnp.split(proj, SPLIT_POINTS, axis=-1)

        lam_init = lambda_init(layer)
        lam = (jnp.exp(jnp.sum(da_lambda_q1[layer].astype(jnp.float32) * da_lambda_k1[layer].astype(jnp.float32)))
               - jnp.exp(jnp.sum(da_lambda_q2[layer].astype(jnp.float32) * da_lambda_k2[layer].astype(jnp.float32)))
               + lam_init)
        y_da = diff_attention(qa.reshape(B, L, DA_HEADS, 2, DA_HEAD_DIM),
                              ka.reshape(B, L, DA_HEADS, 2, DA_HEAD_DIM),
                              va.reshape(B, L, DA_HEADS, DA_VDIM),
                              lam, lam_init, da_head_g[layer])

        o_ret = retention(qr.reshape(B, L, RET_HEADS, RET_QK_DIM),
                          kr.reshape(B, L, RET_HEADS, RET_QK_DIM),
                          vr.reshape(B, L, RET_HEADS, RET_V_DIM))
        y_ret = head_rms(o_ret).reshape(B, L, RET_WIDTH) * jax.nn.silu(gr_out)

        merged = (jax.nn.sigmoid(g_a) * (y_da @ w_proj_da[layer])
                  + jax.nn.sigmoid(g_r) * (y_ret @ w_proj_ret[layer]))
        h = h + merged @ w_out[layer]

        u = rmsnorm(h, norm_mlp_g[layer])
        h = h + jnp.square(jax.nn.relu(u @ w_up[layer])) @ w_down[layer]

    out = rmsnorm(h, final_norm_g)
    return out[:, N_META:]
```

```cpp
#include <hip/hip_runtime.h>
#include <cstdio>
#include <cstdint>
constexpr int NWAVES = 8;
constexpr int BATCH = 8, SEQ = 4096, DM = 1024, NMETA = 16, MR = BATCH * SEQ;
constexpr int DIN = 11264, NQKV = 7168, NGATE = 4096, DFF = 4096;
constexpr int KVROWS = SEQ + 64;
constexpr size_t MiB = 1u << 20;
constexpr size_t WS_CTL = 0, CTL_ZERO_BYTES = 64 * 1024;
constexpr size_t WS_KRM = 1 * MiB;
constexpr size_t WS_VRM = WS_KRM + 64 * 1024;
constexpr size_t WS_SS = 2 * MiB;
constexpr size_t WS_SS2 = 10 * MiB;
constexpr size_t WS_WIN = 12 * MiB;
constexpr size_t WS_WPA = 34 * MiB, WS_WPR = 36 * MiB, WS_WOUT = 40 * MiB, WS_WUP = 42 * MiB, WS_WDN = 50 * MiB;
constexpr size_t WS_U = 58 * MiB;
constexpr size_t WS_QR = 122 * MiB, WS_KR = 186 * MiB;
constexpr size_t WS_VR = 250 * MiB;
constexpr size_t WS_KA = 378 * MiB, WS_VA = 443 * MiB;
constexpr size_t WS_END = 508 * MiB;
constexpr size_t WS_HID = WS_QR, WS_TMP = WS_KA, WS_H1B = WS_KA, WS_MRG = WS_U, WS_SGA = WS_QR, WS_SGR = WS_KR;
static_assert(WS_VA + (size_t)BATCH * KVROWS * 1024 * 2 <= WS_END && WS_TMP + (size_t)MR * 1024 * 4 <= WS_END && WS_HID + (size_t)MR * DFF * 2 <= WS_KA, "ws map");
constexpr int CW_BAR = 4096;

constexpr int RING_BYTES = 131072, LDSCTL_OFF = RING_BYTES, MISC_OFF = LDSCTL_OFF + 320, LDS_BYTES = 147456;


namespace pg8 {
#define PG8_LAS __attribute__((address_space(3)))
typedef unsigned short bf16_t;
typedef short bf16x8 __attribute__((ext_vector_type(8)));
typedef float f32x4 __attribute__((ext_vector_type(4)));
typedef unsigned u32x4 __attribute__((ext_vector_type(4)));
typedef unsigned u32x2 __attribute__((ext_vector_type(2)));
constexpr int BM = 256, BK = 64, HALF = 128, HTB = HALF * BK * 2  , STAGE_BYTES = 8 * HTB, NXCD = 8, WGM = 8;

__host__ __device__ __forceinline__ int lds_byte(int r, int c) { const int st = (r >> 4) * 2 + (c >> 5), rr = r & 15, cc = c & 31, ob = rr * 64 + cc * 2; return st * 1024 + (ob ^ (((ob >> 9) & 1) << 5)); }
__host__ __device__ __forceinline__ void stage_rc(int b, int& R, int& C) { const int st = b / 1024, sb = b % 1024, swz = sb ^ (((sb >> 9) & 1) << 5); R = (st >> 1) * 16 + swz / 64; C = (st & 1) * 32 + (swz % 64) / 2; }
__host__ __device__ __forceinline__ int perm32(int rho) { const int n = rho >> 4, i = rho & 15; return 8 * (i >> 2) + 4 * n + (i & 3); }

struct Unit { int pm, pn; };
struct Gemm { const bf16_t* A; const bf16_t* Bt; int M, N, K; };

struct StaticOrder {
    int nM, nN, nwg, G, c;
    __host__ __device__ void init(int M, int N, int G_, int c_) { nM = M / BM; nN = N / BM; nwg = nM * nN; G = G_; c = c_; }
    __host__ __device__ bool next(int i, Unit& u) const {
        const long L = (long)i * G + c; if (L >= nwg) return false;
        int wgid = (int)L; { const int q = nwg / NXCD, r = nwg % NXCD, xcd = wgid % NXCD, off = wgid / NXCD; wgid = (xcd < r ? xcd * (q + 1) : r * (q + 1) + (xcd - r) * q) + off; }
        const int nig = WGM * nN, gid = wgid / nig, fm = gid * WGM, gsz = (nM - fm) < WGM ? (nM - fm) : WGM;
        u.pm = fm + ((wgid % nig) % gsz); u.pn = (wgid % nig) / gsz; return true;
    }
    __device__ __forceinline__ void a_ready(const Unit&) const {}
    __device__ __forceinline__ void done(const Unit&) const {}
};


typedef float f32x2_t __attribute__((ext_vector_type(2))); typedef __bf16 bf16x2_t __attribute__((ext_vector_type(2)));
__device__ __forceinline__ unsigned cvt_pk_bf16(float lo, float hi) { f32x2_t v = {lo, hi}; bf16x2_t b = __builtin_convertvector(v, bf16x2_t); return __builtin_bit_cast(unsigned, b); }
__device__ __forceinline__ u32x4 pack8(f32x4 a, f32x4 b) { u32x4 w; w.x = cvt_pk_bf16(a[0], a[1]); w.y = cvt_pk_bf16(a[2], a[3]); w.z = cvt_pk_bf16(b[0], b[1]); w.w = cvt_pk_bf16(b[2], b[3]); return w; }
__device__ __forceinline__ void unpack8(u32x4 w, f32x4& a, f32x4& b) {
    a[0] = __uint_as_float(w.x << 16); a[1] = __uint_as_float(w.x & 0xffff0000u); a[2] = __uint_as_float(w.y << 16); a[3] = __uint_as_float(w.y & 0xffff0000u);
    b[0] = __uint_as_float(w.z << 16); b[1] = __uint_as_float(w.z & 0xffff0000u); b[2] = __uint_as_float(w.w << 16); b[3] = __uint_as_float(w.w & 0xffff0000u); }
__device__ __forceinline__ float sigmoidf_(float g) { return __builtin_amdgcn_rcpf(1.0f + __builtin_amdgcn_exp2f(-1.4426950408889634f * g)); }
constexpr float QSCALE = 0.125f * 1.4426950408889634f;
constexpr float NEPS = 1e-6f;

struct EpiQKV {
    static constexpr bool PERM = true, AFTER_DRAIN = false;
    bf16_t* QA; unsigned char* ws;
    __device__ __forceinline__ void operator()(const f32x4 (&acc)[2][2][4][2], const Unit& u, int wr, int wc, int fr, int fq) const {
        const int pn = u.pn; int row0 = u.pm * BM + wr * 64 + fr; int ldc = 1024; float sc = 1.f;
        const int prow = row0 + 64 * ((u.pm * BM) >> 12) + 64;
        const int grp = pn < 20 ? (pn >> 2) : 5, colt = (pn - 4 * grp) * 256;
        size_t boff = 0;
        if (grp == 0) sc = QSCALE;
        else if (grp == 1) { boff = WS_KA; row0 = prow; }
        else if (grp == 2) { boff = WS_VA; row0 = prow; }
        else if (grp == 3) boff = WS_QR;
        else if (grp == 4) { boff = WS_KR; sc = 0.0625f; }
        else { boff = WS_VR; ldc = 2048; }
        bf16_t* base = grp == 0 ? QA : (bf16_t*)(ws + boff);
        const int col0 = colt + wc * 32 + 8 * fq;
#pragma unroll
        for (int ai = 0; ai < 2; ++ai)
#pragma unroll
            for (int m = 0; m < 4; ++m) { bf16_t* rowp = base + (size_t)(row0 + ai * HALF + m * 16) * ldc + col0;
#pragma unroll
                for (int bj = 0; bj < 2; ++bj) *(u32x4*)(rowp + bj * HALF) = pack8(acc[ai][bj][m][0] * sc, acc[ai][bj][m][1] * sc); }
    }
};
struct EpiGates {
    static constexpr bool PERM = true, AFTER_DRAIN = false;
    unsigned char* ws; const float* SS;
    __device__ __forceinline__ void operator()(const f32x4 (&acc)[2][2][4][2], const Unit& u, int wr, int wc, int fr, int fq) const {
        const int pn = u.pn; const int row0 = u.pm * BM + wr * 64 + fr; const bool isy = pn < 8;
        const size_t boff = isy ? WS_VR : (pn < 12 ? WS_SGA : WS_SGR); bf16_t* base = (bf16_t*)(ws + boff); const int ldc = isy ? 2048 : 1024;
        const int col0 = (isy ? pn : (pn < 12 ? pn - 8 : pn - 12)) * 256 + wc * 32 + 8 * fq;
        const float* ssb = SS + (isy ? (pn >> 1) * 16 : 0);
#pragma unroll
        for (int ai = 0; ai < 2; ++ai)
#pragma unroll
            for (int m = 0; m < 4; ++m) { const int row = row0 + ai * HALF + m * 16; bf16_t* rowp = base + (size_t)row * ldc + col0;
                float rinv = 1.f;
                if (isy) { const f32x4* sp = (const f32x4*)(ssb + (size_t)row * 64); const f32x4 s4 = (sp[0] + sp[1]) + (sp[2] + sp[3]);
                    rinv = rsqrtf(((s4[0] + s4[1]) + (s4[2] + s4[3])) * (1.0f / 512.0f) + NEPS); }
#pragma unroll
                for (int bj = 0; bj < 2; ++bj) { f32x4 g0 = acc[ai][bj][m][0], g1 = acc[ai][bj][m][1];
#pragma unroll
                    for (int e = 0; e < 4; ++e) { g0[e] = sigmoidf_(g0[e]); g1[e] = sigmoidf_(g1[e]); }
                    if (isy) { f32x4 o0, o1; unpack8(*(const u32x4*)(rowp + bj * HALF), o0, o1); g0 = g0 * acc[ai][bj][m][0] * o0 * rinv; g1 = g1 * acc[ai][bj][m][1] * o1 * rinv; }
                    *(u32x4*)(rowp + bj * HALF) = pack8(g0, g1); }
                asm volatile("" ::: "memory"); }
    }
};
struct EpiMergeA {
    static constexpr bool PERM = true, AFTER_DRAIN = false;
    const bf16_t* SG; float* TMP;
    __device__ __forceinline__ void operator()(const f32x4 (&acc)[2][2][4][2], const Unit& u, int wr, int wc, int fr, int fq) const {
        const int row0 = u.pm * BM + wr * 64 + fr, col0 = u.pn * BM + wc * 32 + 8 * fq;
#pragma unroll
        for (int ai = 0; ai < 2; ++ai)
#pragma unroll
            for (int m = 0; m < 4; ++m)
#pragma unroll
                for (int bj = 0; bj < 2; ++bj) { const size_t off = (size_t)(row0 + ai * HALF + m * 16) * 1024 + col0 + bj * HALF; f32x4 s0, s1; unpack8(*(const u32x4*)(SG + off), s0, s1);
                    *(f32x4*)(TMP + off) = s0 * acc[ai][bj][m][0]; *(f32x4*)(TMP + off + 4) = s1 * acc[ai][bj][m][1]; }
    }
};
struct EpiMergeB {
    static constexpr bool PERM = true, AFTER_DRAIN = false;
    const bf16_t* SG; const float* TMP; bf16_t* MRG;
    __device__ __forceinline__ void operator()(const f32x4 (&acc)[2][2][4][2], const Unit& u, int wr, int wc, int fr, int fq) const {
        const int row0 = u.pm * BM + wr * 64 + fr, col0 = u.pn * BM + wc * 32 + 8 * fq;
#pragma unroll
        for (int ai = 0; ai < 2; ++ai)
#pragma unroll
            for (int m = 0; m < 4; ++m)
#pragma unroll
                for (int bj = 0; bj < 2; ++bj) { const size_t off = (size_t)(row0 + ai * HALF + m * 16) * 1024 + col0 + bj * HALF; f32x4 s0, s1; unpack8(*(const u32x4*)(SG + off), s0, s1);
                    const f32x4 t0 = *(const f32x4*)(TMP + off), t1 = *(const f32x4*)(TMP + off + 4);
                    *(u32x4*)(MRG + off) = pack8(t0 + s0 * acc[ai][bj][m][0], t1 + s1 * acc[ai][bj][m][1]); }
    }
};
struct EpiOut {
    static constexpr bool PERM = true, AFTER_DRAIN = false;
    const float* X; float* H1; bf16_t* H1B; float* SS2;
    __device__ __forceinline__ void operator()(const f32x4 (&acc)[2][2][4][2], const Unit& u, int wr, int wc, int fr, int fq) const {
        const int row0 = u.pm * BM + wr * 64 + fr, col0 = u.pn * BM + wc * 32 + 8 * fq;
#pragma unroll
        for (int ai = 0; ai < 2; ++ai)
#pragma unroll
            for (int m = 0; m < 4; ++m) { const int row = row0 + ai * HALF + m * 16; float ss = 0.f;
#pragma unroll
                for (int bj = 0; bj < 2; ++bj) { const size_t off = (size_t)row * 1024 + col0 + bj * HALF;
                    const f32x4 h0 = *(const f32x4*)(X + off) + acc[ai][bj][m][0], h1 = *(const f32x4*)(X + off + 4) + acc[ai][bj][m][1];
                    *(f32x4*)(H1 + off) = h0; *(f32x4*)(H1 + off + 4) = h1; *(u32x4*)(H1B + off) = pack8(h0, h1);
                    ss += (h0[0] * h0[0] + h0[1] * h0[1]) + (h0[2] * h0[2] + h0[3] * h0[3]) + (h1[0] * h1[0] + h1[1] * h1[1]) + (h1[2] * h1[2] + h1[3] * h1[3]); }
                ss += __shfl_xor(ss, 16); ss += __shfl_xor(ss, 32);
                if (fq == 0) SS2[(size_t)row * 16 + u.pn * 4 + wc] = ss; }
    }
};
struct EpiUp {
    static constexpr bool PERM = true, AFTER_DRAIN = false;
    const float* SS2; bf16_t* HID;
    __device__ __forceinline__ void operator()(const f32x4 (&acc)[2][2][4][2], const Unit& u, int wr, int wc, int fr, int fq) const {
        const int row0 = u.pm * BM + wr * 64 + fr, col0 = u.pn * BM + wc * 32 + 8 * fq;
#pragma unroll
        for (int ai = 0; ai < 2; ++ai)
#pragma unroll
            for (int m = 0; m < 4; ++m) { const int row = row0 + ai * HALF + m * 16;
                const f32x4* sp = (const f32x4*)(SS2 + (size_t)row * 16); const f32x4 s4 = (sp[0] + sp[1]) + (sp[2] + sp[3]);
                const float rstd = rsqrtf(((s4[0] + s4[1]) + (s4[2] + s4[3])) * (1.0f / 1024.0f) + NEPS);
#pragma unroll
                for (int bj = 0; bj < 2; ++bj) { f32x4 v0 = acc[ai][bj][m][0] * rstd, v1 = acc[ai][bj][m][1] * rstd;
#pragma unroll
                    for (int e = 0; e < 4; ++e) { v0[e] = fmaxf(v0[e], 0.f); v0[e] *= v0[e]; v1[e] = fmaxf(v1[e], 0.f); v1[e] *= v1[e]; }
                    *(u32x4*)(HID + (size_t)row * 4096 + col0 + bj * HALF) = pack8(v0, v1); } }
    }
};
struct EpiDown {
    static constexpr bool PERM = true, AFTER_DRAIN = false;
    float* H;
    __device__ __forceinline__ void operator()(const f32x4 (&acc)[2][2][4][2], const Unit& u, int wr, int wc, int fr, int fq) const {
        const int row0 = u.pm * BM + wr * 64 + fr, col0 = u.pn * BM + wc * 32 + 8 * fq;
#pragma unroll
        for (int ai = 0; ai < 2; ++ai)
#pragma unroll
            for (int m = 0; m < 4; ++m)
#pragma unroll
                for (int bj = 0; bj < 2; ++bj) { float* p = H + (size_t)(row0 + ai * HALF + m * 16) * 1024 + col0 + bj * HALF;
                    const f32x4 h0 = *(const f32x4*)p + acc[ai][bj][m][0], h1 = *(const f32x4*)(p + 4) + acc[ai][bj][m][1]; *(f32x4*)p = h0; *(f32x4*)(p + 4) = h1; }
    }
};

template <class Epi, class Sched, bool ALIGN_EPI = false, bool SP2 = false>
__device__ __forceinline__ void gemm_phase(PG8_LAS unsigned char* lds, const Gemm g, const Sched& S, const Epi& E, const int tid) {
    const int wid = __builtin_amdgcn_readfirstlane(tid >> 6), lane = tid & 63, wr = wid >> 2, wc = wid & 3, fr = lane & 15, fq = lane >> 4;
    const int K = g.K, nt = K / BK;
    unsigned voffA[2], voffB[2];
#pragma unroll
    for (int i = 0; i < 2; ++i) { int R, C; stage_rc(tid * 16 + i * 8192, R, C); const int Rb = Epi::PERM ? ((R & ~31) + perm32(R & 31)) : R;
        voffA[i] = (unsigned)(R * K + C) * 2u; voffB[i] = (unsigned)(Rb * K + C) * 2u; }
    const size_t kstep = (size_t)(BK * 2);
    const size_t hstep = (size_t)HALF * K * 2;
    const size_t tstep = 2 * hstep;
    const unsigned ldsw = (unsigned)wid * 1024u;
    const int aoff = lds_byte(wr * 64 + fr, fq * 8), boff = lds_byte(wc * 32 + fr, fq * 8);
#define PG8_SA(b, h) (((b) * 2 + (h)) * HTB)
#define PG8_SB(b, h) ((4 + (b) * 2 + (h)) * HTB)
#define PG8_STAGE(bufoff, gbase, voff) do { _Pragma("unroll") for (int _i = 0; _i < 2; ++_i) \
        __builtin_amdgcn_global_load_lds((const unsigned*)((const char*)(gbase) + (voff)[_i]), (PG8_LAS unsigned*)(lds + (bufoff) + ldsw + _i * 8192), 16, 0, 0); } while (0)
#define PG8_LDA(dst, b, h) do { _Pragma("unroll") for (int m = 0; m < 4; ++m) _Pragma("unroll") for (int k = 0; k < 2; ++k) dst[m][k] = *(const PG8_LAS bf16x8*)(lds + PG8_SA(b, h) + aoff + m * 2048 + k * 1024); } while (0)
#define PG8_LDB(dst, b, h) do { _Pragma("unroll") for (int n = 0; n < 2; ++n) _Pragma("unroll") for (int k = 0; k < 2; ++k) dst[n][k] = *(const PG8_LAS bf16x8*)(lds + PG8_SB(b, h) + boff + n * 2048 + k * 1024); } while (0)
#define PG8_MMA(ai, bj, At, Bt) do { __builtin_amdgcn_s_setprio(1); _Pragma("unroll") for (int m = 0; m < 4; ++m) _Pragma("unroll") for (int n = 0; n < 2; ++n) _Pragma("unroll") for (int k = 0; k < 2; ++k) \
        acc[ai][bj][m][n] = __builtin_amdgcn_mfma_f32_16x16x32_bf16(Bt[n][k], At[m][k], acc[ai][bj][m][n], 0, 0, 0); __builtin_amdgcn_s_setprio(0); } while (0)
#define PG8_WAIT_V(n) asm volatile("s_waitcnt vmcnt(" #n ")" ::: "memory")
#define PG8_WAIT_L(n) asm volatile("s_waitcnt lgkmcnt(" #n ")" ::: "memory")
#define PG8_BAR __builtin_amdgcn_s_barrier()
#define PG8_SCHED __builtin_amdgcn_sched_barrier(0)
    Unit cur, nxt; int ui = 0;
    if (!S.next(0, cur)) return;
    f32x4 acc[2][2][4][2];
#pragma unroll
    for (int a = 0; a < 2; ++a)
#pragma unroll
        for (int b = 0; b < 2; ++b)
#pragma unroll
            for (int m = 0; m < 4; ++m)
#pragma unroll
                for (int n = 0; n < 2; ++n) acc[a][b][m][n] = (f32x4){0.f, 0.f, 0.f, 0.f};
    bf16x8 At[4][2], B0[2][2], B1[2][2];
    const char* cA = (const char*)g.A + (size_t)cur.pm * tstep; const char* cB = (const char*)g.Bt + (size_t)cur.pn * tstep;
    S.a_ready(cur);
    if constexpr (SP2) {
        PG8_STAGE(PG8_SB(0, 0), cB, voffB); PG8_STAGE(PG8_SB(0, 1), cB + hstep, voffB); PG8_STAGE(PG8_SA(0, 0), cA, voffA); PG8_STAGE(PG8_SA(0, 1), cA + hstep, voffA);
        if (wr == 1) PG8_BAR;
        PG8_WAIT_V(2); PG8_BAR;
        PG8_STAGE(PG8_SB(1, 0), cB + kstep, voffB); PG8_STAGE(PG8_SA(1, 0), cA + kstep, voffA); PG8_STAGE(PG8_SB(1, 1), cB + hstep + kstep, voffB);
        PG8_WAIT_V(6); PG8_BAR;
    } else {
        PG8_STAGE(PG8_SB(0, 0), cB, voffB); PG8_STAGE(PG8_SA(0, 0), cA, voffA); PG8_STAGE(PG8_SB(0, 1), cB + hstep, voffB); PG8_STAGE(PG8_SA(0, 1), cA + hstep, voffA);
        if (wr == 1) PG8_BAR;
        PG8_WAIT_V(4); PG8_BAR;
        PG8_STAGE(PG8_SB(1, 0), cB + kstep, voffB); PG8_STAGE(PG8_SA(1, 0), cA + kstep, voffA); PG8_STAGE(PG8_SB(1, 1), cB + hstep + kstep, voffB);
        PG8_WAIT_V(6); PG8_BAR;
    }
    for (;;) {
        const bool has_next = S.next(ui + 1, nxt);
        const char* nA = has_next ? (const char*)g.A + (size_t)nxt.pm * tstep : cA; const char* nB = has_next ? (const char*)g.Bt + (size_t)nxt.pn * tstep : cB;
        for (int t = 0; t < nt; t += 2) {
            const bool last = (t == nt - 2);
            const char* a1 = cA + (size_t)(t + 1) * kstep;
            const char* a2 = last ? nA : cA + (size_t)(t + 2) * kstep; const char* b2 = last ? nB : cB + (size_t)(t + 2) * kstep;
            const char* a3 = a2 + kstep; const char* b3 = b2 + kstep;
            if (last && has_next) S.a_ready(nxt);
            if constexpr (SP2) {
            PG8_LDB(B0, 0, 0); PG8_LDB(B1, 0, 1); PG8_SCHED; PG8_LDA(At, 0, 0); PG8_STAGE(PG8_SA(1, 1), a1 + hstep, voffA);
            PG8_WAIT_V(8); PG8_WAIT_L(0); PG8_BAR; PG8_MMA(0, 0, At, B0); PG8_MMA(0, 1, At, B1); PG8_BAR; PG8_SCHED;
            PG8_LDA(At, 0, 1); PG8_STAGE(PG8_SB(0, 0), b2, voffB); PG8_STAGE(PG8_SB(0, 1), b2 + hstep, voffB); PG8_STAGE(PG8_SA(0, 0), a2, voffA);
            PG8_WAIT_V(8); PG8_WAIT_L(0); PG8_BAR; PG8_MMA(1, 0, At, B0); PG8_MMA(1, 1, At, B1); PG8_BAR; PG8_SCHED;
            PG8_LDB(B0, 1, 0); PG8_LDB(B1, 1, 1); PG8_SCHED; PG8_LDA(At, 1, 0); PG8_STAGE(PG8_SA(0, 1), a2 + hstep, voffA);
            PG8_WAIT_V(8); PG8_WAIT_L(0); PG8_BAR; PG8_MMA(0, 0, At, B0); PG8_MMA(0, 1, At, B1); PG8_BAR; PG8_SCHED;
            PG8_LDA(At, 1, 1); PG8_STAGE(PG8_SB(1, 0), b3, voffB); PG8_STAGE(PG8_SB(1, 1), b3 + hstep, voffB); PG8_STAGE(PG8_SA(1, 0), a3, voffA);
            PG8_WAIT_V(8); PG8_WAIT_L(0); PG8_BAR; PG8_MMA(1, 0, At, B0); PG8_MMA(1, 1, At, B1); PG8_BAR; PG8_SCHED;
            } else {
            PG8_LDB(B0, 0, 0); PG8_SCHED; PG8_LDA(At, 0, 0); PG8_STAGE(PG8_SA(1, 1), a1 + hstep, voffA);
            PG8_WAIT_L(8); PG8_BAR; PG8_WAIT_L(0); PG8_MMA(0, 0, At, B0); PG8_BAR; PG8_SCHED;
            PG8_LDB(B1, 0, 1); PG8_STAGE(PG8_SB(0, 0), b2, voffB);
            PG8_BAR; PG8_WAIT_L(0); PG8_MMA(0, 1, At, B1); PG8_BAR;
            PG8_LDA(At, 0, 1); PG8_STAGE(PG8_SA(0, 0), a2, voffA);
            PG8_BAR; PG8_WAIT_L(0); PG8_MMA(1, 0, At, B0); PG8_BAR; PG8_SCHED;
            PG8_STAGE(PG8_SB(0, 1), b2 + hstep, voffB);
            PG8_WAIT_V(6); PG8_BAR; PG8_MMA(1, 1, At, B1); PG8_BAR;
            PG8_LDB(B0, 1, 0); PG8_SCHED; PG8_LDA(At, 1, 0); PG8_STAGE(PG8_SA(0, 1), a2 + hstep, voffA);
            PG8_WAIT_L(8); PG8_BAR; PG8_WAIT_L(0); PG8_MMA(0, 0, At, B0); PG8_BAR; PG8_SCHED;
            PG8_LDB(B1, 1, 1); PG8_STAGE(PG8_SB(1, 0), b3, voffB);
            PG8_BAR; PG8_WAIT_L(0); PG8_MMA(0, 1, At, B1); PG8_BAR;
            PG8_LDA(At, 1, 1); PG8_STAGE(PG8_SA(1, 0), a3, voffA);
            PG8_BAR; PG8_WAIT_L(0); PG8_MMA(1, 0, At, B0); PG8_BAR; PG8_SCHED;
            PG8_STAGE(PG8_SB(1, 1), b3 + hstep, voffB);
            PG8_WAIT_V(6); PG8_BAR; PG8_MMA(1, 1, At, B1); PG8_BAR;
            }
        }
        if constexpr (ALIGN_EPI) { if (wr == 0) PG8_BAR; }
        if constexpr (!Epi::AFTER_DRAIN) { E(acc, cur, wr, wc, fr, fq); S.done(cur); }
        if (!has_next) break;
#pragma unroll
        for (int a = 0; a < 2; ++a)
#pragma unroll
            for (int b = 0; b < 2; ++b)
#pragma unroll
                for (int m = 0; m < 4; ++m)
#pragma unroll
                    for (int n = 0; n < 2; ++n) acc[a][b][m][n] = (f32x4){0.f, 0.f, 0.f, 0.f};
        cur = nxt; cA = nA; cB = nB; ++ui;
        if constexpr (ALIGN_EPI) { if (wr == 1) PG8_BAR; }
    }
    PG8_WAIT_V(0);
    if constexpr (!ALIGN_EPI) { if (wr == 0) PG8_BAR; }
    PG8_BAR;
    if constexpr (Epi::AFTER_DRAIN) { E.fused(acc, cur, wr, wc, fr, fq, lds, wid, lane); S.done(cur); }
#undef PG8_SA
#undef PG8_SB
#undef PG8_STAGE
#undef PG8_LDA
#undef PG8_LDB
#undef PG8_MMA
#undef PG8_WAIT_V
#undef PG8_WAIT_L
#undef PG8_BAR
#undef PG8_SCHED
}
}


#define GAS __attribute__((address_space(1)))
#define LAS __attribute__((address_space(3)))
typedef unsigned short bf16;
typedef unsigned v4u __attribute__((ext_vector_type(4)));
typedef float f32x4 __attribute__((ext_vector_type(4)));
typedef short bf16x8 __attribute__((ext_vector_type(8)));
typedef GAS unsigned gu32;
typedef GAS unsigned long long gu64;
#define RLX_AGENT __ATOMIC_RELAXED, __HIP_MEMORY_SCOPE_AGENT
#define LDS_WAIT() asm volatile("s_waitcnt lgkmcnt(0)" ::: "memory")
#define VM_WAIT() asm volatile("s_waitcnt vmcnt(0)" ::: "memory")
__device__ __forceinline__ unsigned long long rt() { return __builtin_amdgcn_s_memrealtime(); }
__device__ __forceinline__ unsigned f2bf(float f) { unsigned u = __builtin_bit_cast(unsigned, f); return (u + 0x7fffu + ((u >> 16) & 1u)) >> 16; }
__device__ __forceinline__ unsigned pk2(float lo, float hi) { return f2bf(lo) | (f2bf(hi) << 16); }

#define XB_TMO      128
#define XB_XCNT(j)  (256  + 64 * (j))
#define XB_XSUB(j)  (1280 + 64 * (j))
#define XB_XGEN(j)  (2304 + 64 * (j))
#define XB_TOP      3328
#define XB_TOPGEN   3392
#define XCD_BAR_WORDS 3456
#define XB_SPIN_CAP (1u << 18)

__device__ __forceinline__ unsigned xb_ld(unsigned* p)              { return __hip_atomic_load(p, __ATOMIC_RELAXED, __HIP_MEMORY_SCOPE_AGENT); }
__device__ __forceinline__ unsigned xb_add(unsigned* p, unsigned v) { return __hip_atomic_fetch_add(p, v, __ATOMIC_RELAXED, __HIP_MEMORY_SCOPE_AGENT); }
__device__ __forceinline__ unsigned xb_xcc_id() { return (unsigned)__builtin_amdgcn_s_getreg((3 << 11) | 20) & 0xFu; }
#define XB_SPIN(cond, bar) do { unsigned _sp = 0; while (cond) { __builtin_amdgcn_s_sleep(1); \
    if ((++_sp & 255u) == 0u) { if (xb_ld(&(bar)[XB_TMO])) break; if (_sp > XB_SPIN_CAP) { atomicAdd(&(bar)[XB_TMO], 1u); break; } } } } while (0)

struct XcdBarrier {
    unsigned* bar; unsigned x;
    volatile LAS unsigned* st;
};

__device__ __forceinline__ XcdBarrier xcd_barrier_post(unsigned* bar, volatile LAS unsigned* st) {
    XcdBarrier b; b.bar = bar; b.x = xb_xcc_id(); b.st = st;
    if (threadIdx.x == 0) (void)xb_add(&bar[XB_XCNT(b.x)], 1u);
    return b;
}
__device__ __forceinline__ void xcd_barrier_complete(unsigned* bar, unsigned x, unsigned& nloc, unsigned& nx) {
    const unsigned G = gridDim.x * gridDim.y * gridDim.z;
    unsigned sum, cnt, mine, sp = 0u;
    for (;;) {
        sum = 0u; cnt = 0u; mine = 0u;
#pragma unroll
        for (unsigned j = 0; j < 16; ++j) { const unsigned c = xb_ld(&bar[XB_XCNT(j)]); sum += c; cnt += (c > 0u) ? 1u : 0u; mine = (j == x) ? c : mine; }
        if (sum == G) break;
        __builtin_amdgcn_s_sleep(1);
        if ((++sp & 255u) == 0u) { if (xb_ld(&bar[XB_TMO])) break; if (sp > XB_SPIN_CAP) { atomicAdd(&bar[XB_TMO], 1u); break; } }
    }
    nloc = mine > 0u ? mine : 1u; nx = cnt > 0u ? cnt : 1u;
}

__device__ __forceinline__ void xcd_barrier(const XcdBarrier& b) {
    asm volatile("s_waitcnt vmcnt(0)" ::: "memory");
    __syncthreads();
    if (threadIdx.x == 0) {
        unsigned* bar = b.bar;
        __builtin_amdgcn_s_waitcnt(0);
        unsigned nloc = b.st[0], nx = b.st[1];
        if (nloc == 0u) { xcd_barrier_complete(bar, b.x, nloc, nx); b.st[0] = nloc; b.st[1] = nx; }
        const unsigned old = xb_add(&bar[XB_XSUB(b.x)], 1u);
        const unsigned gen = old / nloc;
        if (old + 1u == (gen + 1u) * nloc) {
            __builtin_amdgcn_fence(__ATOMIC_RELEASE, "agent");
            asm volatile("s_waitcnt vmcnt(0)" ::: "memory");
            const unsigned og = xb_add(&bar[XB_TOP], 1u);
            const unsigned tg = og / nx;
            if (og + 1u == (tg + 1u) * nx) xb_add(&bar[XB_TOPGEN], 1u);
            else XB_SPIN(xb_ld(&bar[XB_TOPGEN]) == tg, bar);
            __builtin_amdgcn_fence(__ATOMIC_ACQUIRE, "agent");
            xb_add(&bar[XB_XGEN(b.x)], 1u);
            asm volatile("s_waitcnt vmcnt(0)" ::: "memory");
        } else {
            XB_SPIN(xb_ld(&bar[XB_XGEN(b.x)]) == gen, bar);
            __builtin_amdgcn_fence(__ATOMIC_ACQUIRE, "agent");
            asm volatile("s_waitcnt vmcnt(0)" ::: "memory");
        }
    }
    __syncthreads();
}

typedef unsigned u32x2 __attribute__((ext_vector_type(2)));

__device__ __forceinline__ float wave_sum(float v) {
#pragma unroll
    for (int o = 1; o < 64; o <<= 1) v += __shfl_xor(v, o);
    return v;
}
__device__ __forceinline__ void p0_transpose_item(const float* W, int K, int N, bf16* WT, const float* kscale, LAS float* scr, int item, int lane) {
    const int nblk = N / 32, kb = item / nblk, nb = item % nblk, k0 = 64 * kb, n0 = 32 * nb;
#pragma unroll 8
    for (int i = 0; i < 32; ++i) { const int kk = 2 * i + (lane >> 5); float v = W[(size_t)(k0 + kk) * N + n0 + (lane & 31)]; if (kscale) v *= kscale[k0 + kk]; scr[kk * 33 + (lane & 31)] = v; }
    LDS_WAIT(); asm volatile("" ::: "memory");
    const int c = lane & 7;
#pragma unroll
    for (int j = 0; j < 4; ++j) { const int n = (lane >> 3) + 8 * j; const LAS float* s = scr + (8 * c) * 33 + n;
        v4u o; o.x = pk2(s[0 * 33], s[1 * 33]); o.y = pk2(s[2 * 33], s[3 * 33]); o.z = pk2(s[4 * 33], s[5 * 33]); o.w = pk2(s[6 * 33], s[7 * 33]);
        *(GAS v4u*)(WT + (size_t)(n0 + n) * K + k0 + 8 * c) = o; }
    LDS_WAIT(); asm volatile("" ::: "memory");
}
__device__ __forceinline__ void rms_row_to_bf16(const float* xrow, const float* g, bf16* orow, int lane) {
    const GAS f32x4* xr = (const GAS f32x4*)xrow + lane; const GAS f32x4* gr = (const GAS f32x4*)g + lane;
    f32x4 v[4]; float s = 0.f;
#pragma unroll
    for (int j = 0; j < 4; ++j) { v[j] = xr[64 * j]; s += (v[j].x * v[j].x + v[j].y * v[j].y) + (v[j].z * v[j].z + v[j].w * v[j].w); }
    const float rstd = rsqrtf(wave_sum(s) * (1.f / 1024.f) + 1e-6f);
    GAS unsigned long long* o8 = (GAS unsigned long long*)orow + lane;
#pragma unroll
    for (int j = 0; j < 4; ++j) { const f32x4 gg = gr[64 * j];
        o8[64 * j] = (unsigned long long)pk2(v[j].x * rstd * gg.x, v[j].y * rstd * gg.y) | ((unsigned long long)pk2(v[j].z * rstd * gg.z, v[j].w * rstd * gg.w) << 32); }
}
__device__ __forceinline__ void p0_meta_item(LAS unsigned char* lds, int item, const float* meta, const float* g1, const float* w_in, bf16* KA, bf16* VA, float* KRM, float* VRM, int tid) {
    const int lane = tid & 63, wid = tid >> 6;
    LAS float* um = (LAS float*)lds;
    LAS float* part = (LAS float*)(lds + 65536);
    for (int rr = 0; rr < 2; ++rr) { const int r = wid * 2 + rr; const float* xrow = meta + r * 1024;
        f32x4 v[4]; float s = 0.f;
#pragma unroll
        for (int j = 0; j < 4; ++j) { v[j] = *((const f32x4*)xrow + lane + 64 * j); s += (v[j].x * v[j].x + v[j].y * v[j].y) + (v[j].z * v[j].z + v[j].w * v[j].w); }
        const float rstd = rsqrtf(wave_sum(s) * (1.f / 1024.f) + 1e-6f);
#pragma unroll
        for (int j = 0; j < 4; ++j) { const f32x4 gg = *((const f32x4*)g1 + lane + 64 * j); f32x4 o = v[j] * rstd * gg; *((LAS f32x4*)(um + r * 1024) + lane + 64 * j) = o; } }
    __syncthreads();
    const int j0 = item * 64 + lane;
    const int wcol = j0 < 2048 ? 1024 + j0 : 4096 + (j0 - 2048);
    float acc[16];
#pragma unroll
    for (int r = 0; r < 16; ++r) acc[r] = 0.f;
    const int kbeg = wid * 128;
    for (int k = kbeg; k < kbeg + 128; k += 4) {
        float wv[4];
#pragma unroll
        for (int q = 0; q < 4; ++q) wv[q] = w_in[(size_t)(k + q) * DIN + wcol];
#pragma unroll
        for (int r = 0; r < 16; ++r) { const f32x4 uu = *(const LAS f32x4*)(um + r * 1024 + k); acc[r] += uu.x * wv[0] + uu.y * wv[1] + uu.z * wv[2] + uu.w * wv[3]; }
    }
#pragma unroll
    for (int r = 0; r < 16; ++r) part[(wid * 16 + r) * 64 + lane] = acc[r];
    __syncthreads();
    for (int o = tid; o < 1024; o += 512) { const int r = o >> 6, l = o & 63; float s = 0.f;
#pragma unroll
        for (int w = 0; w < 8; ++w) s += part[(w * 16 + r) * 64 + l];
        const int j = item * 64 + l;
        if (j < 2048) { bf16* dst = j < 1024 ? KA : VA; const int col = j & 1023; const bf16 hv = (bf16)f2bf(s);
            for (int b = 0; b < BATCH; ++b) dst[(size_t)(b * KVROWS + 48 + r) * 1024 + col] = hv; }
        else if (j < 3072) KRM[r * 1024 + (j - 2048)] = s * 0.0625f;
        else VRM[r * 2048 + (j - 3072)] = s; }
    __syncthreads();
}

namespace att {
typedef float f32x16 __attribute__((ext_vector_type(16)));
typedef short s16x4 __attribute__((ext_vector_type(4)));
typedef short v4i16_t __attribute__((ext_vector_type(4)));
constexpr int KSTR = 272, VSTR = 320, KBUF = 64 * KSTR, VBUF = 64 * VSTR;
constexpr int OFF_K = 0, OFF_V = 2 * KBUF, OFF_WS = OFF_V + 2 * VBUF, LDS_END = OFF_WS + 8 * 256;
constexpr int XSTR = 528;
static_assert(4 * 32 * XSTR <= OFF_WS && LDS_END <= RING_BYTES, "attention LDS map");
__device__ __forceinline__ int crow(int r, int hi) { return (r & 3) + 8 * (r >> 2) + 4 * hi; }
__device__ __forceinline__ s16x4 vtr(const LAS unsigned char* p) { return __builtin_bit_cast(s16x4, __builtin_amdgcn_ds_read_tr16_b64_v4i16((LAS v4i16_t*)p)); }
__device__ __forceinline__ float swapmax(float m) { auto rr = __builtin_amdgcn_permlane32_swap(__float_as_uint(m), __float_as_uint(m), false, false); return fmaxf(__uint_as_float(rr[0]), __uint_as_float(rr[1])); }
__device__ __forceinline__ float swapsum(float m) { auto rr = __builtin_amdgcn_permlane32_swap(__float_as_uint(m), __float_as_uint(m), false, false); return __uint_as_float(rr[0]) + __uint_as_float(rr[1]); }

__device__ __forceinline__ void attn_unit(LAS unsigned char* lds, int b, int h, int qblk, const bf16* QA, const bf16* KA, const bf16* VA, bf16* YDA, float lam, const float* headg, float slope2, const int tid) {
    const int lane = tid & 63, r32 = lane & 31, hi = lane >> 5, wid = __builtin_amdgcn_readfirstlane(tid >> 6), c = wid & 1, qg = wid >> 1;
    const int srow = tid >> 4, sch = tid & 15;
    const bf16* KAb = KA + (size_t)b * KVROWS * 1024; const bf16* VAb = VA + (size_t)b * KVROWS * 1024;
    const unsigned soff = (unsigned)(srow * 1024 + h * 128 + sch * 8);
    LAS unsigned char* kdst = lds + OFF_K + srow * KSTR + sch * 16;
    LAS unsigned char* vdst = lds + OFF_V + srow * VSTR + sch * 16;
    const int q_idx = 128 * qblk + 32 * qg + r32;
    bf16x8 qr[4];
    { const bf16* qp = QA + (size_t)(b * SEQ + q_idx) * 1024 + h * 128 + c * 64 + hi * 8;
#pragma unroll
      for (int d0 = 0; d0 < 4; ++d0) qr[d0] = *(const bf16x8*)(qp + d0 * 16); }
    f32x16 base0;
#pragma unroll
    for (int r = 0; r < 16; ++r) base0[r] = slope2 * (float)crow(r, hi);
    const float s32 = 32.f * slope2;
    f32x16 o[4];
#pragma unroll
    for (int d = 0; d < 4; ++d)
#pragma unroll
        for (int r = 0; r < 16; ++r) o[d][r] = 0.f;
    float mref = -1e30f, l = 0.f;
    LAS float* wsf = (LAS float*)(lds + OFF_WS) + wid * 64;
    const int t_hi = 2 * qblk + 1;
    v4u kreg[2], vreg[2];
    { const unsigned toff = (unsigned)((64 + 64 * t_hi) * 1024);
#pragma unroll
      for (int i = 0; i < 2; ++i) { kreg[i] = *(const v4u*)(KAb + (soff + toff + (unsigned)(i * 32 * 1024))); vreg[i] = *(const v4u*)(VAb + (soff + toff + (unsigned)(i * 32 * 1024))); }
#pragma unroll
      for (int i = 0; i < 2; ++i) { *(LAS v4u*)(kdst + i * 32 * KSTR) = kreg[i]; *(LAS v4u*)(vdst + i * 32 * VSTR) = vreg[i]; } }
    __syncthreads();
    int cur = 0;
    for (int t = t_hi; t >= -1; --t) {
        if (t > -1) { const unsigned toff = (unsigned)((64 + 64 * (t - 1)) * 1024);
#pragma unroll
            for (int i = 0; i < 2; ++i) { kreg[i] = *(const v4u*)(KAb + (soff + toff + (unsigned)(i * 32 * 1024))); vreg[i] = *(const v4u*)(VAb + (soff + toff + (unsigned)(i * 32 * 1024))); } }
        const bool active = !(qg < 2 && t == t_hi);
        if (active) {
            const LAS unsigned char* kb = lds + OFF_K + cur * KBUF + c * 128 + hi * 16 + r32 * KSTR;
            f32x16 p0 = base0, p1 = base0;
#pragma unroll
            for (int d0 = 0; d0 < 4; ++d0) { const bf16x8 a0 = *(const LAS bf16x8*)(kb + d0 * 32), a1 = *(const LAS bf16x8*)(kb + 32 * KSTR + d0 * 32);
                p0 = __builtin_amdgcn_mfma_f32_32x32x16_bf16(a0, qr[d0], p0, 0, 0, 0); p1 = __builtin_amdgcn_mfma_f32_32x32x16_bf16(a1, qr[d0], p1, 0, 0, 0); }
            if (t == -1 || 64 * t + 63 > 128 * qblk + 32 * qg) {
                const int kv0 = 64 * t + 4 * hi;
#pragma unroll
                for (int r = 0; r < 16; ++r) { const int kv = kv0 + (r & 3) + 8 * (r >> 2);
                    const bool v0 = (kv <= q_idx) && (t >= 0 || kv >= -16), v1 = (kv + 32 <= q_idx) && (t >= 0 || kv + 32 >= -16);
                    p0[r] = v0 ? p0[r] : -INFINITY; p1[r] = v1 ? p1[r] : -INFINITY; }
            }
            const float toffs = slope2 * 64.f * (float)(t - t_hi);
            float pm = p0[0], pm1 = p1[0];
#pragma unroll
            for (int r = 1; r < 16; ++r) { pm = fmaxf(pm, p0[r]); pm1 = fmaxf(pm1, p1[r]); }
            pm = swapmax(fmaxf(pm, pm1 + s32));
            const float cand = pm + toffs;
            if (__any(cand > mref + 8.0f)) {
                const float mnew = fmaxf(mref, cand), f = __builtin_amdgcn_exp2f(mref - mnew); l *= f; mref = mnew;
                if (hi == 0) wsf[r32] = f;
                float fr[16];
#pragma unroll
                for (int r = 0; r < 16; ++r) fr[r] = wsf[crow(r, hi)];
#pragma unroll
                for (int d = 0; d < 4; ++d)
#pragma unroll
                    for (int r = 0; r < 16; ++r) o[d][r] *= fr[r];
            }
            const float mrel = mref - toffs, mrel1 = mrel - s32;
            float sacc = 0.f;
#pragma unroll
            for (int r = 0; r < 16; ++r) { p0[r] = __builtin_amdgcn_exp2f(p0[r] - mrel); p1[r] = __builtin_amdgcn_exp2f(p1[r] - mrel1); sacc += p0[r] + p1[r]; }
            l += sacc;
            v4u pw[4];
#pragma unroll
            for (int q = 0; q < 4; ++q) { pw[0][q] = pg8::cvt_pk_bf16(p0[2 * q], p0[2 * q + 1]); pw[1][q] = pg8::cvt_pk_bf16(p0[8 + 2 * q], p0[9 + 2 * q]);
                pw[2][q] = pg8::cvt_pk_bf16(p1[2 * q], p1[2 * q + 1]); pw[3][q] = pg8::cvt_pk_bf16(p1[8 + 2 * q], p1[9 + 2 * q]); }
            const LAS unsigned char* vb = lds + OFF_V + cur * VBUF + (4 * hi + ((lane & 15) >> 2)) * VSTR + ((lane >> 4) & 1) * 32 + (lane & 3) * 8;
#pragma unroll
            for (int d0 = 0; d0 < 4; ++d0)
#pragma unroll
                for (int ks = 0; ks < 4; ++ks) { const s16x4 lo = vtr(vb + ks * 16 * VSTR + d0 * 64), hh = vtr(vb + (ks * 16 + 8) * VSTR + d0 * 64);
                    const bf16x8 vf = (bf16x8){lo[0], lo[1], lo[2], lo[3], hh[0], hh[1], hh[2], hh[3]};
                    o[d0] = __builtin_amdgcn_mfma_f32_32x32x16_bf16(__builtin_bit_cast(bf16x8, pw[ks]), vf, o[d0], 0, 0, 0); }
        }
        if (t > -1) {
#pragma unroll
            for (int i = 0; i < 2; ++i) { *(LAS v4u*)(kdst + (cur ^ 1) * KBUF + i * 32 * KSTR) = kreg[i]; *(LAS v4u*)(vdst + (cur ^ 1) * VBUF + i * 32 * VSTR) = vreg[i]; } }
        __syncthreads(); cur ^= 1;
    }
    l = swapsum(l);
    if (hi == 0) wsf[32 + r32] = l;
    float rli[16];
#pragma unroll
    for (int r = 0; r < 16; ++r) rli[r] = 1.0f / wsf[32 + crow(r, hi)];
#pragma unroll
    for (int d = 0; d < 4; ++d)
#pragma unroll
        for (int r = 0; r < 16; ++r) o[d][r] *= rli[r];
    LAS unsigned char* xb = lds + qg * 32 * XSTR;
    if (c == 1) {
#pragma unroll
        for (int d = 0; d < 4; ++d)
#pragma unroll
            for (int r = 0; r < 16; ++r) *(LAS float*)(xb + crow(r, hi) * XSTR + (32 * d + r32) * 4) = o[d][r];
    }
    __syncthreads();
    if (c == 0) {
        float ss[16];
#pragma unroll
        for (int r = 0; r < 16; ++r) ss[r] = 0.f;
#pragma unroll
        for (int d = 0; d < 4; ++d)
#pragma unroll
            for (int r = 0; r < 16; ++r) { const float o2 = *(const LAS float*)(xb + crow(r, hi) * XSTR + (32 * d + r32) * 4); const float v = o[d][r] - lam * o2; o[d][r] = v; ss[r] += v * v; }
#pragma unroll
        for (int r = 0; r < 16; ++r) { float s = ss[r]; s += __shfl_xor(s, 1); s += __shfl_xor(s, 2); s += __shfl_xor(s, 4); s += __shfl_xor(s, 8); s += __shfl_xor(s, 16); ss[r] = rsqrtf(s * (1.0f / 128.0f) + 1e-6f) * 0.8f; }
        bf16* yp = YDA + (size_t)(b * SEQ + 128 * qblk + 32 * qg) * 1024 + h * 128 + r32;
#pragma unroll
        for (int d = 0; d < 4; ++d) { const float hg = headg[32 * d + r32];
#pragma unroll
            for (int r = 0; r < 16; ++r) yp[(size_t)crow(r, hi) * 1024 + 32 * d] = (bf16)f2bf(o[d][r] * ss[r] * hg); }
    }
    __syncthreads();
}
}

namespace ret {
using att::f32x16; using att::s16x4; using att::vtr; using att::crow;
constexpr int QSTR = 272, VPSTR = 144, STSTR = 528;
constexpr int OFF_Q = 0, OFF_KH = 128 * QSTR, OFF_VP = 2 * 128 * QSTR, OFF_ST = OFF_VP + 128 * VPSTR, LDS_END = OFF_ST + 64 * STSTR;
static_assert(LDS_END <= RING_BYTES, "retention LDS map");

template <int HF>
__device__ __forceinline__ void compute_half(LAS unsigned char* lds, int wid, int lane, f32x16& X0, f32x16& X1, f32x16& Cacc, f32x16& S, float g128) {
    const int r32 = lane & 31, hi = lane >> 5;
    { const int kb = wid & 3, qbp = wid >> 2; const bool need0 = kb <= 2 * qbp, need1 = kb <= 2 * qbp + 1;
      if (need1) {
        const LAS unsigned char* kp = lds + OFF_KH + (32 * kb + r32) * QSTR + hi * 16;
        const LAS unsigned char* q0 = lds + OFF_Q + (64 * qbp + r32) * QSTR + hi * 16;
#pragma unroll
        for (int ks = 0; ks < 8; ++ks) { const bf16x8 ka = *(const LAS bf16x8*)(kp + ks * 32);
            if (need0) { const bf16x8 qf = *(const LAS bf16x8*)(q0 + ks * 32); X0 = __builtin_amdgcn_mfma_f32_32x32x16_bf16(ka, qf, X0, 0, 0, 0); }
            const bf16x8 qf1 = *(const LAS bf16x8*)(q0 + 32 * QSTR + ks * 32); X1 = __builtin_amdgcn_mfma_f32_32x32x16_bf16(ka, qf1, X1, 0, 0, 0); }
      } }
    const int qb = wid >> 1, eb = wid & 1;
    { const LAS unsigned char* qp = lds + OFF_Q + (32 * qb + r32) * QSTR + hi * 16;
      const LAS unsigned char* sp = lds + OFF_ST + (32 * eb + r32) * STSTR + HF * 256 + hi * 16;
#pragma unroll
      for (int ks = 0; ks < 8; ++ks) { const bf16x8 qa = *(const LAS bf16x8*)(qp + ks * 32), sb = *(const LAS bf16x8*)(sp + ks * 32);
          Cacc = __builtin_amdgcn_mfma_f32_32x32x16_bf16(qa, sb, Cacc, 0, 0, 0); } }
    { const int dkl = wid >> 1, q4 = (lane & 15) >> 2, g1 = (lane >> 4) & 1, p = lane & 3;
#pragma unroll
      for (int r = 0; r < 16; ++r) S[r] *= g128;
      const LAS unsigned char* kt = lds + OFF_KH + (4 * q4 + 2 * hi) * QSTR + (32 * dkl + 16 * g1 + 4 * p) * 2;
      const LAS unsigned char* vt = lds + OFF_VP + (4 * q4 + 2 * hi) * VPSTR + (32 * eb + 16 * g1 + 4 * p) * 2;
#pragma unroll
      for (int ks = 0; ks < 8; ++ks) { const s16x4 a0 = vtr(kt + ks * 16 * QSTR), a1 = vtr(kt + ks * 16 * QSTR + QSTR), b0 = vtr(vt + ks * 16 * VPSTR), b1 = vtr(vt + ks * 16 * VPSTR + VPSTR);
          const bf16x8 af = (bf16x8){a0[0], a0[1], a0[2], a0[3], a1[0], a1[1], a1[2], a1[3]}, bfr = (bf16x8){b0[0], b0[1], b0[2], b0[3], b1[0], b1[1], b1[2], b1[3]};
          S = __builtin_amdgcn_mfma_f32_32x32x16_bf16(af, bfr, S, 0, 0, 0); } }
}
__device__ __forceinline__ void write_st(LAS unsigned char* lds, int dkb, int eb, int lane, const f32x16& S) {
    const int r32 = lane & 31, hi = lane >> 5; LAS unsigned char* p = lds + OFF_ST + (32 * eb + r32) * STSTR + (32 * dkb + 4 * hi) * 2;
#pragma unroll
    for (int g = 0; g < 4; ++g) { u32x2 w; w.x = pg8::cvt_pk_bf16(S[4 * g], S[4 * g + 1]); w.y = pg8::cvt_pk_bf16(S[4 * g + 2], S[4 * g + 3]); *(LAS u32x2*)(p + g * 16) = w; }
}
__device__ __forceinline__ void write_a(LAS unsigned char* lds, int kb, int qb, int lane, const f32x16& X) {
    const int r32 = lane & 31, hi = lane >> 5, q = 32 * qb + r32; LAS unsigned char* p = lds + OFF_Q + q * QSTR + (32 * kb + 4 * hi) * 2;
#pragma unroll
    for (int g = 0; g < 4; ++g) { const int k = 32 * kb + 8 * g + 4 * hi; float v[4];
#pragma unroll
        for (int j = 0; j < 4; ++j) v[j] = (k + j <= q) ? X[4 * g + j] : 0.f;
        u32x2 w; w.x = pg8::cvt_pk_bf16(v[0], v[1]); w.y = pg8::cvt_pk_bf16(v[2], v[3]); *(LAS u32x2*)(p + g * 16) = w; }
}

__device__ __forceinline__ void ret_item(LAS unsigned char* lds, int b, int h, int sl, const bf16* QR, const bf16* KR, bf16* VR, const float* KRM, const float* VRM, float* SS, const int tid) {
    const int lane = tid & 63, r32 = lane & 31, hi = lane >> 5, wid = __builtin_amdgcn_readfirstlane(tid >> 6);
    const float lg = log2f(1.0f - exp2f(-5.0f - (float)h));
    const float g128 = exp2f(128.f * lg);
    const int qb = wid >> 1, eb = wid & 1, dkl = wid >> 1;
    f32x16 S0, S1;
#pragma unroll
    for (int r = 0; r < 16; ++r) { S0[r] = 0.f; S1[r] = 0.f; }
    for (int m = 0; m < NMETA; ++m) { const float dm = exp2f(lg * (float)(15 - m)), vv = VRM[m * 2048 + h * 512 + sl * 64 + 32 * eb + r32] * dm; const float* kr = KRM + m * 1024 + h * 256 + 32 * dkl;
#pragma unroll
        for (int r = 0; r < 16; ++r) { S0[r] += kr[crow(r, hi)] * vv; S1[r] += kr[128 + crow(r, hi)] * vv; } }
    write_st(lds, dkl, eb, lane, S0); write_st(lds, 4 + dkl, eb, lane, S1);
    const int srow = tid >> 4, sch = tid & 15;
    const int vrow = tid >> 3, vch = tid & 7;
    const size_t rowb = (size_t)b * SEQ;
    const bf16* qsrc = QR + (rowb + srow) * 1024 + h * 256 + sch * 8;
    const bf16* ksrc = KR + (rowb + srow) * 1024 + h * 256 + sch * 8;
    bf16* vsrc = VR + (rowb + vrow) * 2048 + h * 512 + sl * 64 + vch * 8;
    LAS unsigned char* qdst = lds + OFF_Q + srow * QSTR + sch * 16;
    LAS unsigned char* kdst = lds + OFF_KH + srow * QSTR + sch * 16;
    LAS unsigned char* vdst = lds + OFF_VP + vrow * VPSTR + vch * 16;
    float vsc[2];
#pragma unroll
    for (int i = 0; i < 2; ++i) vsc[i] = exp2f(lg * (float)(127 - (vrow + 64 * i)));
    v4u qreg[4], kreg[4], vreg[2];
#pragma unroll
    for (int i = 0; i < 4; ++i) { qreg[i] = *(const v4u*)(qsrc + (size_t)i * 32 * 1024); kreg[i] = *(const v4u*)(ksrc + (size_t)i * 32 * 1024); }
#pragma unroll
    for (int i = 0; i < 2; ++i) vreg[i] = *(const v4u*)(vsrc + (size_t)i * 64 * 2048);
    f32x16 X0, X1, Cacc, T;
#pragma unroll
    for (int r = 0; r < 16; ++r) { X0[r] = 0.f; X1[r] = 0.f; Cacc[r] = 0.f; T[r] = 0.f; }
    for (int c = 0; c < 32; ++c) {
        const size_t coff = (size_t)c * 128;
#pragma unroll
        for (int i = 0; i < 4; ++i) { *(LAS v4u*)(qdst + i * 32 * QSTR) = qreg[i]; *(LAS v4u*)(kdst + i * 32 * QSTR) = kreg[i]; }
#pragma unroll
        for (int i = 0; i < 2; ++i) { pg8::f32x4 a, bq; pg8::unpack8(vreg[i], a, bq); *(LAS v4u*)(vdst + i * 64 * VPSTR) = pg8::pack8(a * vsc[i], bq * vsc[i]); }
#pragma unroll
        for (int i = 0; i < 4; ++i) { qreg[i] = *(const v4u*)(qsrc + (coff + i * 32) * 1024 + 128); kreg[i] = *(const v4u*)(ksrc + (coff + i * 32) * 1024 + 128); }
        __syncthreads();
        compute_half<0>(lds, wid, lane, X0, X1, Cacc, S0, g128);
        __syncthreads();
#pragma unroll
        for (int i = 0; i < 4; ++i) { *(LAS v4u*)(qdst + i * 32 * QSTR) = qreg[i]; *(LAS v4u*)(kdst + i * 32 * QSTR) = kreg[i]; }
        write_st(lds, dkl, eb, lane, S0);
        if (c + 1 < 32) {
#pragma unroll
            for (int i = 0; i < 4; ++i) { qreg[i] = *(const v4u*)(qsrc + (coff + 128 + i * 32) * 1024); kreg[i] = *(const v4u*)(ksrc + (coff + 128 + i * 32) * 1024); }
#pragma unroll
            for (int i = 0; i < 2; ++i) vreg[i] = *(const v4u*)(vsrc + (coff + 128 + i * 64) * 2048);
        }
        __syncthreads();
        compute_half<1>(lds, wid, lane, X0, X1, Cacc, S1, g128);
        __syncthreads();
        write_st(lds, 4 + dkl, eb, lane, S1);
        { const int kb = wid & 3, qbp = wid >> 2;
          if (kb <= 2 * qbp) write_a(lds, kb, 2 * qbp, lane, X0);
          if (kb <= 2 * qbp + 1) write_a(lds, kb, 2 * qbp + 1, lane, X1); }
        __syncthreads();
        { const int q4 = (lane & 15) >> 2, g1 = (lane >> 4) & 1, p = lane & 3;
          const LAS unsigned char* ap = lds + OFF_Q + (32 * qb + r32) * QSTR + hi * 16;
          const LAS unsigned char* vp = lds + OFF_VP + (8 * hi + q4) * VPSTR + (32 * eb + 16 * g1 + 4 * p) * 2;
#pragma unroll
          for (int kb = 0; kb < 4; ++kb) if (kb <= qb) {
#pragma unroll
              for (int s = 0; s < 2; ++s) { const bf16x8 af = *(const LAS bf16x8*)(ap + (32 * kb + 16 * s) * 2);
                  const s16x4 lo = vtr(vp + (32 * kb + 16 * s) * VPSTR), hh = vtr(vp + (32 * kb + 16 * s + 4) * VPSTR);
                  const bf16x8 vf = (bf16x8){lo[0], lo[1], lo[2], lo[3], hh[0], hh[1], hh[2], hh[3]};
                  T = __builtin_amdgcn_mfma_f32_32x32x16_bf16(af, vf, T, 0, 0, 0); } }
          bf16* op = VR + (rowb + coff + 32 * qb) * 2048 + h * 512 + sl * 64 + 32 * eb + r32;
          float* ssp = SS + (rowb + coff + 32 * qb) * 64 + h * 16 + sl * 2 + eb;
          float lgc = lg; asm volatile("" : "+v"(lgc));
#pragma unroll
          for (int r = 0; r < 16; ++r) { const float qf = (float)(32 * qb + crow(r, hi)); const float v = __builtin_amdgcn_exp2f(lgc * (qf - 127.f)) * T[r] + __builtin_amdgcn_exp2f(lgc * (qf + 1.f)) * Cacc[r]; op[(size_t)crow(r, hi) * 2048] = (bf16)f2bf(v);
              float s = v * v; s += __shfl_xor(s, 1); s += __shfl_xor(s, 2); s += __shfl_xor(s, 4); s += __shfl_xor(s, 8); s += __shfl_xor(s, 16);
              if (r32 == 0) ssp[(size_t)crow(r, hi) * 64] = s; }
#pragma unroll
          for (int r = 0; r < 16; ++r) { X0[r] = 0.f; X1[r] = 0.f; Cacc[r] = 0.f; T[r] = 0.f; } }
        __syncthreads();
    }
}
}

#ifndef MK_N_LAUNCHES
#define MK_N_LAUNCHES 11
#endif
constexpr int NPH = 11;
struct Args { const float* in[16]; float* out; unsigned char* ws; int ph_lo, ph_hi; };
__global__ void __launch_bounds__(NWAVES * 64, 2) fwd(Args args) {
    extern __shared__ __attribute__((aligned(16))) unsigned char lds_raw[];
    LAS unsigned char* lds = (LAS unsigned char*)lds_raw;
    volatile LAS unsigned* MISC = (volatile LAS unsigned*)(lds + MISC_OFF);
    const int wave = __builtin_amdgcn_readfirstlane(threadIdx.x >> 6);
#define PHASE_TID const int tid = threadIdx.x; int lane = tid; asm volatile("" : "+v"(lane)); lane &= 63; (void)lane;
    const int G = gridDim.x, bx = blockIdx.x, vcu = (G % 8 == 0) ? (bx % 8) * (G / 8) + bx / 8 : bx;
    typedef __attribute__((address_space(4))) const unsigned char* karg_t;
    karg_t kp0 = (karg_t)__builtin_amdgcn_kernarg_segment_ptr();
#define KARG_IN(i) (*(const float* __attribute__((address_space(4))) const*)(kp + 8 * (i)))
#define PHASE_PTRS \
    karg_t kp = kp0; asm volatile("" : "+s"(kp)); \
    float* out = *(float* __attribute__((address_space(4))) const*)(kp + 128); unsigned char* ws = *(unsigned char* __attribute__((address_space(4))) const*)(kp + 136); \
    bf16* QA = (bf16*)out; (void)QA; (void)ws; PHASE_TID
    gu32* ctl = (gu32*)(args.ws + WS_CTL);
    for (int u = threadIdx.x; u < (LDS_BYTES - LDSCTL_OFF) / 4; u += NWAVES * 64) ((LAS unsigned*)(lds + LDSCTL_OFF))[u] = 0u;
    __syncthreads();
    const int lo = args.ph_lo, hi = args.ph_hi;
    XcdBarrier bar; bar.bar = (unsigned*)(ctl + CW_BAR); bar.x = 0; bar.st = nullptr;
    if (hi - lo > 1) bar = xcd_barrier_post((unsigned*)(ctl + CW_BAR), MISC + 8);
#ifdef ONLY_PHASE
#define IN(k) ((k) == ONLY_PHASE && lo <= (k) && (k) < hi)
#else
#define IN(k) (lo <= (k) && (k) < hi)
#endif
#define SEAM(k) do { if (IN(k) && IN((k) + 1)) xcd_barrier(bar); } while (0)

    if (IN(0)) { PHASE_PTRS
        const float* x = KARG_IN(0); const float* meta = KARG_IN(1); const float* g1 = KARG_IN(2); const float* w_in = KARG_IN(3);
        const float* w_pa = KARG_IN(9); const float* w_pr = KARG_IN(10); const float* w_out = KARG_IN(11); const float* g2 = KARG_IN(12); const float* w_up = KARG_IN(13); const float* w_dn = KARG_IN(14);
        bf16* Win_t = (bf16*)(ws + WS_WIN); bf16* Wpa_t = (bf16*)(ws + WS_WPA); bf16* Wpr_t = (bf16*)(ws + WS_WPR); bf16* Wout_t = (bf16*)(ws + WS_WOUT); bf16* Wup_t = (bf16*)(ws + WS_WUP); bf16* Wdn_t = (bf16*)(ws + WS_WDN);
        bf16* U = (bf16*)(ws + WS_U); bf16* KA = (bf16*)(ws + WS_KA); bf16* VA = (bf16*)(ws + WS_VA); float* KRM = (float*)(ws + WS_KRM); float* VRM = (float*)(ws + WS_VRM);
        if (bx < 80) p0_meta_item(lds, bx, meta, g1, w_in, KA, VA, KRM, VRM, tid);
        {
            const int gt = bx * 512 + tid;
            for (int i = gt; i < 2 * BATCH * 48 * 128; i += G * 512) { const int arr = i / (BATCH * 48 * 128), rem = i % (BATCH * 48 * 128), b = rem / (48 * 128), r2 = rem % (48 * 128);
                bf16* dst = (arr ? VA : KA) + (size_t)b * KVROWS * 1024 + (size_t)r2 * 8; *(v4u*)dst = (v4u){0u, 0u, 0u, 0u}; } }
        LAS float* scr = (LAS float*)(lds + wave * 16384);
        const int gw = vcu * NWAVES + wave, NGW = G * NWAVES;
        constexpr int I_IN = 16 * (DIN / 32), I_PA = 16 * 32, I_PR = 32 * 32, I_OUT = 16 * 32, I_UP = 16 * (DFF / 32), I_DN = 64 * 32;
        constexpr int NITEMS = I_IN + I_PA + I_PR + I_OUT + I_UP + I_DN;
        for (int it = gw; it < NITEMS; it += NGW) {
            int r = it;
            if (r < I_IN) { p0_transpose_item(w_in, 1024, DIN, Win_t, nullptr, scr, r, lane); continue; } r -= I_IN;
            if (r < I_PA) { p0_transpose_item(w_pa, 1024, 1024, Wpa_t, nullptr, scr, r, lane); continue; } r -= I_PA;
            if (r < I_PR) { p0_transpose_item(w_pr, 2048, 1024, Wpr_t, nullptr, scr, r, lane); continue; } r -= I_PR;
            if (r < I_OUT) { p0_transpose_item(w_out, 1024, 1024, Wout_t, nullptr, scr, r, lane); continue; } r -= I_OUT;
            if (r < I_UP) { p0_transpose_item(w_up, 1024, DFF, Wup_t, g2, scr, r, lane); continue; } r -= I_UP;
            p0_transpose_item(w_dn, DFF, 1024, Wdn_t, nullptr, scr, r, lane);
        }
        for (int m = gw; m < MR; m += NGW) rms_row_to_bf16(x + (size_t)m * 1024, g1, U + (size_t)m * 1024, lane);
    }
    SEAM(0);
    if (IN(1)) { PHASE_PTRS bf16* U = (bf16*)(ws + WS_U); bf16* Win_t = (bf16*)(ws + WS_WIN);
        pg8::Gemm g{U, Win_t, MR, NQKV, 1024}; pg8::StaticOrder S; S.init(MR, NQKV, G, bx); pg8::EpiQKV E{QA, ws};
        pg8::gemm_phase<pg8::EpiQKV, pg8::StaticOrder, true, true>(lds, g, S, E, tid); }
    SEAM(1);
    if (IN(2)) { PHASE_PTRS bf16* KA = (bf16*)(ws + WS_KA); bf16* VA = (bf16*)(ws + WS_VA);
        float lam;
        { const float* lq1 = KARG_IN(4); const float* lk1 = KARG_IN(5); const float* lq2 = KARG_IN(6); const float* lk2 = KARG_IN(7); float s1 = 0.f, s2 = 0.f;
          for (int i = 0; i < 64; ++i) { s1 += lq1[i] * lk1[i]; s2 += lq2[i] * lk2[i]; }
          lam = expf(s1) - expf(s2) + 0.2f; }
        const float* headg = KARG_IN(8);
        for (int i = 0; i < 4; ++i) { const int pid = vcu * 4 + i; if (pid >= 1024) break; const int bh = pid >> 4, s = pid & 15, b = bh >> 3, h = bh & 7;
            const float slope2 = exp2f(-(float)(h + 1)) * 1.4426950408889634f;
            att::attn_unit(lds, b, h, 31 - s, QA, KA, VA, QA, lam, headg, slope2, tid);
            att::attn_unit(lds, b, h, s, QA, KA, VA, QA, lam, headg, slope2, tid); }
    }
    SEAM(2);
    if (IN(3)) { PHASE_PTRS bf16* QR = (bf16*)(ws + WS_QR); bf16* KR = (bf16*)(ws + WS_KR); bf16* VR = (bf16*)(ws + WS_VR); float* KRM = (float*)(ws + WS_KRM); float* VRM = (float*)(ws + WS_VRM); float* SS = (float*)(ws + WS_SS);
        for (int it = vcu; it < 256; it += G) ret::ret_item(lds, it >> 5, (it >> 3) & 3, it & 7, QR, KR, VR, KRM, VRM, SS, tid); }
    SEAM(3);
    if (IN(4)) { PHASE_PTRS bf16* U = (bf16*)(ws + WS_U); bf16* Win_t = (bf16*)(ws + WS_WIN); float* SS = (float*)(ws + WS_SS);
        pg8::Gemm g{U, Win_t + (size_t)NQKV * 1024, MR, NGATE, 1024}; pg8::StaticOrder S; S.init(MR, NGATE, G, bx); pg8::EpiGates E{ws, SS};
        pg8::gemm_phase<pg8::EpiGates, pg8::StaticOrder, true, true>(lds, g, S, E, tid); }
    SEAM(4);
    if (IN(5)) { PHASE_PTRS bf16* Wpa_t = (bf16*)(ws + WS_WPA); bf16* SGA = (bf16*)(ws + WS_SGA); float* TMP = (float*)(ws + WS_TMP);
        pg8::Gemm g{QA, Wpa_t, MR, 1024, 1024}; pg8::StaticOrder S; S.init(MR, 1024, G, bx); pg8::EpiMergeA E{SGA, TMP};
        pg8::gemm_phase<pg8::EpiMergeA, pg8::StaticOrder, true, true>(lds, g, S, E, tid); }
    SEAM(5);
    if (IN(6)) { PHASE_PTRS bf16* VR = (bf16*)(ws + WS_VR); bf16* Wpr_t = (bf16*)(ws + WS_WPR); bf16* SGR = (bf16*)(ws + WS_SGR); float* TMP = (float*)(ws + WS_TMP); bf16* MRG = (bf16*)(ws + WS_MRG);
        pg8::Gemm g{VR, Wpr_t, MR, 1024, 2048}; pg8::StaticOrder S; S.init(MR, 1024, G, bx); pg8::EpiMergeB E{SGR, TMP, MRG};
        pg8::gemm_phase<pg8::EpiMergeB, pg8::StaticOrder, true, true>(lds, g, S, E, tid); }
    SEAM(6);
    if (IN(7)) { PHASE_PTRS const float* x = KARG_IN(0); bf16* MRG = (bf16*)(ws + WS_MRG); bf16* Wout_t = (bf16*)(ws + WS_WOUT); bf16* H1B = (bf16*)(ws + WS_H1B); float* SS2 = (float*)(ws + WS_SS2);
        pg8::Gemm g{MRG, Wout_t, MR, 1024, 1024}; pg8::StaticOrder S; S.init(MR, 1024, G, bx); pg8::EpiOut E{x, out, H1B, SS2};
        pg8::gemm_phase<pg8::EpiOut, pg8::StaticOrder, true, true>(lds, g, S, E, tid); }
    SEAM(7);
    if (IN(8)) { PHASE_PTRS bf16* H1B = (bf16*)(ws + WS_H1B); bf16* Wup_t = (bf16*)(ws + WS_WUP); float* SS2 = (float*)(ws + WS_SS2); bf16* HID = (bf16*)(ws + WS_HID);
        pg8::Gemm g{H1B, Wup_t, MR, DFF, 1024}; pg8::StaticOrder S; S.init(MR, DFF, G, bx); pg8::EpiUp E{SS2, HID};
        pg8::gemm_phase<pg8::EpiUp, pg8::StaticOrder, true, true>(lds, g, S, E, tid); }
    SEAM(8);
    if (IN(9)) { PHASE_PTRS bf16* HID = (bf16*)(ws + WS_HID); bf16* Wdn_t = (bf16*)(ws + WS_WDN);
        pg8::Gemm g{HID, Wdn_t, MR, 1024, DFF}; pg8::StaticOrder S; S.init(MR, 1024, G, bx); pg8::EpiDown E{out};
        pg8::gemm_phase<pg8::EpiDown, pg8::StaticOrder, true, true>(lds, g, S, E, tid); }
    SEAM(9);
    if (IN(10)) { PHASE_PTRS const float* gf = KARG_IN(15); const int gw = vcu * NWAVES + wave, NGW = G * NWAVES;
        for (int m = gw; m < MR; m += NGW) { GAS f32x4* xr = (GAS f32x4*)(out + (size_t)m * 1024) + lane; const GAS f32x4* gr = (const GAS f32x4*)gf + lane;
            f32x4 v[4]; float s = 0.f;
#pragma unroll
            for (int j = 0; j < 4; ++j) { v[j] = xr[64 * j]; s += (v[j].x * v[j].x + v[j].y * v[j].y) + (v[j].z * v[j].z + v[j].w * v[j].w); }
            const float rstd = rsqrtf(wave_sum(s) * (1.f / 1024.f) + 1e-6f);
#pragma unroll
            for (int j = 0; j < 4; ++j) xr[64 * j] = v[j] * rstd * gr[64 * j]; } }
#undef IN
#undef SEAM
}

extern "C" void kernel_launch(void* const* d_in, const int* in_sizes, int n_in, void* d_out, int out_size, void* d_ws, size_t ws_size, hipStream_t stream) {
    static int grid = 0;
    if (grid == 0) {
        if (n_in != 16 || in_sizes[0] != MR * 1024 || out_size != MR * 1024 || ws_size < WS_END) { fprintf(stderr, "kernel_launch: unexpected shapes / workspace (n_in %d, in0 %d, out %d, ws %zu); nothing launched\n", n_in, n_in > 0 ? in_sizes[0] : -1, out_size, ws_size); grid = -1; return; }
        int dev = 0, cus = 0;
        if (hipGetDevice(&dev) != hipSuccess || hipDeviceGetAttribute(&cus, hipDeviceAttributeMultiprocessorCount, dev) != hipSuccess) { grid = -1; return; }
        if (hipFuncSetAttribute((const void*)fwd, hipFuncAttributeMaxDynamicSharedMemorySize, LDS_BYTES) != hipSuccess) { fprintf(stderr, "kernel_launch: hipFuncSetAttribute failed\n"); grid = -1; return; }
        (void)hipGetLastError();
        grid = cus;
    }
    if (grid < 0) return;
    (void)hipMemsetAsync((char*)d_ws + WS_CTL, 0, CTL_ZERO_BYTES, stream);
    Args a{};
    for (int i = 0; i < 16; ++i) a.in[i] = (const float*)d_in[i];
    a.out = (float*)d_out; a.ws = (unsigned char*)d_ws;
#if MK_N_LAUNCHES == 1
    a.ph_lo = 0; a.ph_hi = NPH; hipLaunchKernelGGL(fwd, dim3(grid), dim3(NWAVES * 64), LDS_BYTES, stream, a);
#else
    for (int ph = 0; ph < NPH; ++ph) { a.ph_lo = ph; a.ph_hi = ph + 1; hipLaunchKernelGGL(fwd, dim3(grid), dim3(NWAVES * 64), LDS_BYTES, stream, a); }
#endif
}
```

```cpp
#include <hip/hip_runtime.h>
#include <cstdio>
#include <cstdint>
constexpr int NWAVES = 8;
constexpr int BATCH = 8, SEQ = 4096, DM = 1024, NMETA = 16, MR = BATCH * SEQ;
constexpr int DIN = 11264, NQKV = 7168, NGATE = 4096, DFF = 4096;
constexpr int KVROWS = SEQ + 64;
constexpr size_t MiB = 1u << 20;
constexpr size_t WS_CTL = 0, CTL_ZERO_BYTES = 64 * 1024;
constexpr size_t WS_KRM = 1 * MiB;
constexpr size_t WS_VRM = WS_KRM + 64 * 1024;
constexpr size_t WS_SS = 2 * MiB;
constexpr size_t WS_SS2 = 10 * MiB;
constexpr size_t WS_WIN = 12 * MiB;
constexpr size_t WS_WPA = 34 * MiB, WS_WPR = 36 * MiB, WS_WOUT = 40 * MiB, WS_WUP = 42 * MiB, WS_WDN = 50 * MiB;
constexpr size_t WS_U = 58 * MiB;
constexpr size_t WS_QR = 122 * MiB, WS_KR = 186 * MiB;
constexpr size_t WS_VR = 250 * MiB;
constexpr size_t WS_KA = 378 * MiB, WS_VA = 443 * MiB;
constexpr size_t WS_END = 508 * MiB;
constexpr size_t WS_HID = WS_QR, WS_TMP = WS_KA, WS_H1B = WS_KA, WS_MRG = WS_U, WS_SGA = WS_QR, WS_SGR = WS_KR;
static_assert(WS_VA + (size_t)BATCH * KVROWS * 1024 * 2 <= WS_END && WS_TMP + (size_t)MR * 1024 * 4 <= WS_END && WS_HID + (size_t)MR * DFF * 2 <= WS_KA, "ws map");
constexpr int CW_BAR = 4096;
constexpr int CW_KN = 8192;
constexpr int CW_QUEUE = 1024;

constexpr int RING_BYTES = 131072, LDSCTL_OFF = RING_BYTES, MISC_OFF = LDSCTL_OFF + 320, LDS_BYTES = 147456;


namespace pg8 {
#define PG8_LAS __attribute__((address_space(3)))
typedef unsigned short bf16_t;
typedef short bf16x8 __attribute__((ext_vector_type(8)));
typedef float f32x4 __attribute__((ext_vector_type(4)));
typedef unsigned u32x4 __attribute__((ext_vector_type(4)));
typedef unsigned u32x2 __attribute__((ext_vector_type(2)));
constexpr int BM = 256, BK = 64, HALF = 128, HTB = HALF * BK * 2  , STAGE_BYTES = 8 * HTB, NXCD = 8, WGM = 8;

__host__ __device__ __forceinline__ int lds_byte(int r, int c) { const int st = (r >> 4) * 2 + (c >> 5), rr = r & 15, cc = c & 31, ob = rr * 64 + cc * 2; return st * 1024 + (ob ^ (((ob >> 9) & 1) << 5)); }
__host__ __device__ __forceinline__ void stage_rc(int b, int& R, int& C) { const int st = b / 1024, sb = b % 1024, swz = sb ^ (((sb >> 9) & 1) << 5); R = (st >> 1) * 16 + swz / 64; C = (st & 1) * 32 + (swz % 64) / 2; }
__host__ __device__ __forceinline__ int perm32(int rho) { const int n = rho >> 4, i = rho & 15; return 8 * (i >> 2) + 4 * n + (i & 3); }

struct Unit { int pm, pn; };
struct Gemm { const bf16_t* A; const bf16_t* Bt; int M, N, K; };

struct StaticOrder {
    int nM, nN, nwg, G, c;
    __host__ __device__ void init(int M, int N, int G_, int c_) { nM = M / BM; nN = N / BM; nwg = nM * nN; G = G_; c = c_; }
    __host__ __device__ bool next(int i, Unit& u) const {
        const long L = (long)i * G + c; if (L >= nwg) return false;
        int wgid = (int)L; { const int q = nwg / NXCD, r = nwg % NXCD, xcd = wgid % NXCD, off = wgid / NXCD; wgid = (xcd < r ? xcd * (q + 1) : r * (q + 1) + (xcd - r) * q) + off; }
        const int nig = WGM * nN, gid = wgid / nig, fm = gid * WGM, gsz = (nM - fm) < WGM ? (nM - fm) : WGM;
        u.pm = fm + ((wgid % nig) % gsz); u.pn = (wgid % nig) / gsz; return true;
    }
    __device__ __forceinline__ void a_ready(const Unit&) const {}
    __device__ __forceinline__ void done(const Unit&) const {}
};


typedef float f32x2_t __attribute__((ext_vector_type(2))); typedef __bf16 bf16x2_t __attribute__((ext_vector_type(2)));
__device__ __forceinline__ unsigned cvt_pk_bf16(float lo, float hi) { f32x2_t v = {lo, hi}; bf16x2_t b = __builtin_convertvector(v, bf16x2_t); return __builtin_bit_cast(unsigned, b); }
__device__ __forceinline__ u32x4 pack8(f32x4 a, f32x4 b) { u32x4 w; w.x = cvt_pk_bf16(a[0], a[1]); w.y = cvt_pk_bf16(a[2], a[3]); w.z = cvt_pk_bf16(b[0], b[1]); w.w = cvt_pk_bf16(b[2], b[3]); return w; }
__device__ __forceinline__ void unpack8(u32x4 w, f32x4& a, f32x4& b) {
    a[0] = __uint_as_float(w.x << 16); a[1] = __uint_as_float(w.x & 0xffff0000u); a[2] = __uint_as_float(w.y << 16); a[3] = __uint_as_float(w.y & 0xffff0000u);
    b[0] = __uint_as_float(w.z << 16); b[1] = __uint_as_float(w.z & 0xffff0000u); b[2] = __uint_as_float(w.w << 16); b[3] = __uint_as_float(w.w & 0xffff0000u); }
__device__ __forceinline__ float sigmoidf_(float g) { return __builtin_amdgcn_rcpf(1.0f + __builtin_amdgcn_exp2f(-1.4426950408889634f * g)); }
constexpr float QSCALE = 0.125f * 1.4426950408889634f;
constexpr float NEPS = 1e-6f;

struct EpiQKV {
    static constexpr bool PERM = true, AFTER_DRAIN = false;
    bf16_t* QA; unsigned char* ws;
    __device__ __forceinline__ void operator()(const f32x4 (&acc)[2][2][4][2], const Unit& u, int wr, int wc, int fr, int fq) const {
        const int pn = u.pn; const int row0 = u.pm * BM + wr * 64 + fr; int ldc = 1024; float sc = 1.f;
        const int grp = pn < 20 ? (pn >> 2) : 5, colt = (pn - 4 * grp) * 256;
        if (grp == 1 || grp == 2) {
            bf16_t* base = (bf16_t*)(ws + (grp == 1 ? WS_KA : WS_VA));
            const int b = (u.pm * BM) >> 12, srow = (row0 & 4095) + 64, hcol = wc * 32 + 8 * fq;
#pragma unroll
            for (int bj = 0; bj < 2; ++bj) { bf16_t* hb = base + ((size_t)(b * 8 + 2 * (pn & 3) + bj) * KVROWS + srow) * 128 + hcol; float mx = 0.f;
#pragma unroll
                for (int ai = 0; ai < 2; ++ai)
#pragma unroll
                    for (int m = 0; m < 4; ++m) { const f32x4 a0 = acc[ai][bj][m][0], a1 = acc[ai][bj][m][1]; *(u32x4*)(hb + (size_t)(ai * HALF + m * 16) * 128) = pack8(a0, a1);
                        mx = fmaxf(mx, (a0[0] * a0[0] + a0[1] * a0[1]) + (a0[2] * a0[2] + a0[3] * a0[3]) + (a1[0] * a1[0] + a1[1] * a1[1]) + (a1[2] * a1[2] + a1[3] * a1[3])); }
                if (grp == 1) {
                    mx = fmaxf(mx, __shfl_xor(mx, 1)); mx = fmaxf(mx, __shfl_xor(mx, 2)); mx = fmaxf(mx, __shfl_xor(mx, 4)); mx = fmaxf(mx, __shfl_xor(mx, 8));
                    if (fr == 0) atomicMax((unsigned*)(ws + WS_CTL) + CW_KN + ((b * 8 + 2 * (pn & 3) + bj) * 2 + (wc >> 1)) * 8 + ((wc & 1) * 4 + fq), __float_as_uint(mx)); } }
            return;
        }
        size_t boff = 0;
        if (grp == 0) sc = QSCALE;
        else if (grp == 3) boff = WS_QR;
        else if (grp == 4) { boff = WS_KR; sc = 0.0625f; }
        else { boff = WS_VR; ldc = 2048; }
        bf16_t* base = grp == 0 ? QA : (bf16_t*)(ws + boff);
        const int col0 = colt + wc * 32 + 8 * fq;
#pragma unroll
        for (int ai = 0; ai < 2; ++ai)
#pragma unroll
            for (int m = 0; m < 4; ++m) { bf16_t* rowp = base + (size_t)(row0 + ai * HALF + m * 16) * ldc + col0;
#pragma unroll
                for (int bj = 0; bj < 2; ++bj) *(u32x4*)(rowp + bj * HALF) = pack8(acc[ai][bj][m][0] * sc, acc[ai][bj][m][1] * sc); }
    }
};
struct EpiGates {
    static constexpr bool PERM = true, AFTER_DRAIN = false;
    unsigned char* ws; const float* SS;
    __device__ __forceinline__ void operator()(const f32x4 (&acc)[2][2][4][2], const Unit& u, int wr, int wc, int fr, int fq) const {
        const int pn = u.pn; const int row0 = u.pm * BM + wr * 64 + fr; const bool isy = pn < 8;
        const size_t boff = isy ? WS_VR : (pn < 12 ? WS_SGA : WS_SGR); bf16_t* base = (bf16_t*)(ws + boff); const int ldc = isy ? 2048 : 1024;
        const int col0 = (isy ? pn : (pn < 12 ? pn - 8 : pn - 12)) * 256 + wc * 32 + 8 * fq;
        const float* ssb = SS + (isy ? (pn >> 1) * 16 : 0);
#pragma unroll
        for (int ai = 0; ai < 2; ++ai)
#pragma unroll
            for (int m = 0; m < 4; ++m) { const int row = row0 + ai * HALF + m * 16; bf16_t* rowp = base + (size_t)row * ldc + col0;
                float rinv = 1.f;
                if (isy) { const f32x4* sp = (const f32x4*)(ssb + (size_t)row * 64); const f32x4 s4 = (sp[0] + sp[1]) + (sp[2] + sp[3]);
                    rinv = rsqrtf(((s4[0] + s4[1]) + (s4[2] + s4[3])) * (1.0f / 512.0f) + NEPS); }
#pragma unroll
                for (int bj = 0; bj < 2; ++bj) { f32x4 g0 = acc[ai][bj][m][0], g1 = acc[ai][bj][m][1];
#pragma unroll
                    for (int e = 0; e < 4; ++e) { g0[e] = sigmoidf_(g0[e]); g1[e] = sigmoidf_(g1[e]); }
                    if (isy) { f32x4 o0, o1; unpack8(*(const u32x4*)(rowp + bj * HALF), o0, o1); g0 = g0 * acc[ai][bj][m][0] * o0 * rinv; g1 = g1 * acc[ai][bj][m][1] * o1 * rinv; }
                    *(u32x4*)(rowp + bj * HALF) = pack8(g0, g1); }
                asm volatile("" ::: "memory"); }
    }
};
struct EpiMergeA {
    static constexpr bool PERM = true, AFTER_DRAIN = false;
    const bf16_t* SG; bf16_t* TMP;
    __device__ __forceinline__ void operator()(const f32x4 (&acc)[2][2][4][2], const Unit& u, int wr, int wc, int fr, int fq) const {
        const int row0 = u.pm * BM + wr * 64 + fr, col0 = u.pn * BM + wc * 32 + 8 * fq;
#pragma unroll
        for (int ai = 0; ai < 2; ++ai)
#pragma unroll
            for (int m = 0; m < 4; ++m)
#pragma unroll
                for (int bj = 0; bj < 2; ++bj) { const size_t off = (size_t)(row0 + ai * HALF + m * 16) * 1024 + col0 + bj * HALF; f32x4 s0, s1; unpack8(*(const u32x4*)(SG + off), s0, s1);
                    *(u32x4*)(TMP + off) = pack8(s0 * acc[ai][bj][m][0], s1 * acc[ai][bj][m][1]); }
    }
};
struct EpiMergeB {
    static constexpr bool PERM = true, AFTER_DRAIN = false;
    const bf16_t* SG; const bf16_t* TMP; bf16_t* MRG;
    __device__ __forceinline__ void operator()(const f32x4 (&acc)[2][2][4][2], const Unit& u, int wr, int wc, int fr, int fq) const {
        const int row0 = u.pm * BM + wr * 64 + fr, col0 = u.pn * BM + wc * 32 + 8 * fq;
#pragma unroll
        for (int ai = 0; ai < 2; ++ai)
#pragma unroll
            for (int m = 0; m < 4; ++m)
#pragma unroll
                for (int bj = 0; bj < 2; ++bj) { const size_t off = (size_t)(row0 + ai * HALF + m * 16) * 1024 + col0 + bj * HALF; f32x4 s0, s1; unpack8(*(const u32x4*)(SG + off), s0, s1);
                    f32x4 t0, t1; unpack8(*(const u32x4*)(TMP + off), t0, t1);
                    *(u32x4*)(MRG + off) = pack8(t0 + s0 * acc[ai][bj][m][0], t1 + s1 * acc[ai][bj][m][1]); }
    }
};
struct EpiOut {
    static constexpr bool PERM = true, AFTER_DRAIN = false;
    const float* X; float* H1; bf16_t* H1B; float* SS2;
    __device__ __forceinline__ void operator()(const f32x4 (&acc)[2][2][4][2], const Unit& u, int wr, int wc, int fr, int fq) const {
        const int row0 = u.pm * BM + wr * 64 + fr, col0 = u.pn * BM + wc * 32 + 8 * fq;
#pragma unroll
        for (int ai = 0; ai < 2; ++ai)
#pragma unroll
            for (int m = 0; m < 4; ++m) { const int row = row0 + ai * HALF + m * 16; float ss = 0.f;
#pragma unroll
                for (int bj = 0; bj < 2; ++bj) { const size_t off = (size_t)row * 1024 + col0 + bj * HALF;
                    const f32x4 h0 = *(const f32x4*)(X + off) + acc[ai][bj][m][0], h1 = *(const f32x4*)(X + off + 4) + acc[ai][bj][m][1];
                    *(f32x4*)(H1 + off) = h0; *(f32x4*)(H1 + off + 4) = h1; *(u32x4*)(H1B + off) = pack8(h0, h1);
                    ss += (h0[0] * h0[0] + h0[1] * h0[1]) + (h0[2] * h0[2] + h0[3] * h0[3]) + (h1[0] * h1[0] + h1[1] * h1[1]) + (h1[2] * h1[2] + h1[3] * h1[3]); }
                ss += __shfl_xor(ss, 16); ss += __shfl_xor(ss, 32);
                if (fq == 0) SS2[(size_t)row * 16 + u.pn * 4 + wc] = ss; }
    }
};
struct EpiUp {
    static constexpr bool PERM = true, AFTER_DRAIN = false;
    const float* SS2; bf16_t* HID;
    __device__ __forceinline__ void operator()(const f32x4 (&acc)[2][2][4][2], const Unit& u, int wr, int wc, int fr, int fq) const {
        const int row0 = u.pm * BM + wr * 64 + fr, col0 = u.pn * BM + wc * 32 + 8 * fq;
#pragma unroll
        for (int ai = 0; ai < 2; ++ai)
#pragma unroll
            for (int m = 0; m < 4; ++m) { const int row = row0 + ai * HALF + m * 16;
                const f32x4* sp = (const f32x4*)(SS2 + (size_t)row * 16); const f32x4 s4 = (sp[0] + sp[1]) + (sp[2] + sp[3]);
                const float rstd = rsqrtf(((s4[0] + s4[1]) + (s4[2] + s4[3])) * (1.0f / 1024.0f) + NEPS);
#pragma unroll
                for (int bj = 0; bj < 2; ++bj) { f32x4 v0 = acc[ai][bj][m][0] * rstd, v1 = acc[ai][bj][m][1] * rstd;
#pragma unroll
                    for (int e = 0; e < 4; ++e) { v0[e] = fmaxf(v0[e], 0.f); v0[e] *= v0[e]; v1[e] = fmaxf(v1[e], 0.f); v1[e] *= v1[e]; }
                    *(u32x4*)(HID + (size_t)row * 4096 + col0 + bj * HALF) = pack8(v0, v1); } }
    }
};
struct EpiDown {
    static constexpr bool PERM = true, AFTER_DRAIN = false;
    float* H;
    __device__ __forceinline__ void operator()(const f32x4 (&acc)[2][2][4][2], const Unit& u, int wr, int wc, int fr, int fq) const {
        const int row0 = u.pm * BM + wr * 64 + fr, col0 = u.pn * BM + wc * 32 + 8 * fq;
#pragma unroll
        for (int ai = 0; ai < 2; ++ai)
#pragma unroll
            for (int m = 0; m < 4; ++m)
#pragma unroll
                for (int bj = 0; bj < 2; ++bj) { float* p = H + (size_t)(row0 + ai * HALF + m * 16) * 1024 + col0 + bj * HALF;
                    const f32x4 h0 = *(const f32x4*)p + acc[ai][bj][m][0], h1 = *(const f32x4*)(p + 4) + acc[ai][bj][m][1]; *(f32x4*)p = h0; *(f32x4*)(p + 4) = h1; }
    }
};

template <class Epi, class Sched, bool ALIGN_EPI = false, bool SP2 = false>
__device__ __forceinline__ void gemm_phase(PG8_LAS unsigned char* lds, const Gemm g, const Sched& S, const Epi& E, const int tid) {
    const int wid = __builtin_amdgcn_readfirstlane(tid >> 6), lane = tid & 63, wr = wid >> 2, wc = wid & 3, fr = lane & 15, fq = lane >> 4;
    const int K = g.K, nt = K / BK;
    unsigned voffA[2], voffB[2];
#pragma unroll
    for (int i = 0; i < 2; ++i) { int R, C; stage_rc(tid * 16 + i * 8192, R, C); const int Rb = Epi::PERM ? ((R & ~31) + perm32(R & 31)) : R;
        voffA[i] = (unsigned)(R * K + C) * 2u; voffB[i] = (unsigned)(Rb * K + C) * 2u; }
    const size_t kstep = (size_t)(BK * 2);
    const size_t hstep = (size_t)HALF * K * 2;
    const size_t tstep = 2 * hstep;
    const unsigned ldsw = (unsigned)wid * 1024u;
    const int aoff = lds_byte(wr * 64 + fr, fq * 8), boff = lds_byte(wc * 32 + fr, fq * 8);
#define PG8_SA(b, h) (((b) * 2 + (h)) * HTB)
#define PG8_SB(b, h) ((4 + (b) * 2 + (h)) * HTB)
#define PG8_STAGE(bufoff, gbase, voff) do { _Pragma("unroll") for (int _i = 0; _i < 2; ++_i) \
        __builtin_amdgcn_global_load_lds((const unsigned*)((const char*)(gbase) + (voff)[_i]), (PG8_LAS unsigned*)(lds + (bufoff) + ldsw + _i * 8192), 16, 0, 0); } while (0)
#define PG8_LDA(dst, b, h) do { _Pragma("unroll") for (int m = 0; m < 4; ++m) _Pragma("unroll") for (int k = 0; k < 2; ++k) dst[m][k] = *(const PG8_LAS bf16x8*)(lds + PG8_SA(b, h) + aoff + m * 2048 + k * 1024); } while (0)
#define PG8_LDB(dst, b, h) do { _Pragma("unroll") for (int n = 0; n < 2; ++n) _Pragma("unroll") for (int k = 0; k < 2; ++k) dst[n][k] = *(const PG8_LAS bf16x8*)(lds + PG8_SB(b, h) + boff + n * 2048 + k * 1024); } while (0)
#define PG8_MMA(ai, bj, At, Bt) do { __builtin_amdgcn_s_setprio(1); _Pragma("unroll") for (int m = 0; m < 4; ++m) _Pragma("unroll") for (int n = 0; n < 2; ++n) _Pragma("unroll") for (int k = 0; k < 2; ++k) \
        acc[ai][bj][m][n] = __builtin_amdgcn_mfma_f32_16x16x32_bf16(Bt[n][k], At[m][k], acc[ai][bj][m][n], 0, 0, 0); __builtin_amdgcn_s_setprio(0); } while (0)
#define PG8_WAIT_V(n) asm volatile("s_waitcnt vmcnt(" #n ")" ::: "memory")
#define PG8_WAIT_L(n) asm volatile("s_waitcnt lgkmcnt(" #n ")" ::: "memory")
#define PG8_BAR __builtin_amdgcn_s_barrier()
#define PG8_SCHED __builtin_amdgcn_sched_barrier(0)
    Unit cur, nxt; int ui = 0;
    if (!S.next(0, cur)) return;
    f32x4 acc[2][2][4][2];
#pragma unroll
    for (int a = 0; a < 2; ++a)
#pragma unroll
        for (int b = 0; b < 2; ++b)
#pragma unroll
            for (int m = 0; m < 4; ++m)
#pragma unroll
                for (int n = 0; n < 2; ++n) acc[a][b][m][n] = (f32x4){0.f, 0.f, 0.f, 0.f};
    bf16x8 At[4][2], B0[2][2], B1[2][2];
    const char* cA = (const char*)g.A + (size_t)cur.pm * tstep; const char* cB = (const char*)g.Bt + (size_t)cur.pn * tstep;
    S.a_ready(cur);
    if constexpr (SP2) {
        PG8_STAGE(PG8_SB(0, 0), cB, voffB); PG8_STAGE(PG8_SB(0, 1), cB + hstep, voffB); PG8_STAGE(PG8_SA(0, 0), cA, voffA); PG8_STAGE(PG8_SA(0, 1), cA + hstep, voffA);
        if (wr == 1) PG8_BAR;
        PG8_WAIT_V(2); PG8_BAR;
        PG8_STAGE(PG8_SB(1, 0), cB + kstep, voffB); PG8_STAGE(PG8_SA(1, 0), cA + kstep, voffA); PG8_STAGE(PG8_SB(1, 1), cB + hstep + kstep, voffB);
        PG8_WAIT_V(6); PG8_BAR;
    } else {
        PG8_STAGE(PG8_SB(0, 0), cB, voffB); PG8_STAGE(PG8_SA(0, 0), cA, voffA); PG8_STAGE(PG8_SB(0, 1), cB + hstep, voffB); PG8_STAGE(PG8_SA(0, 1), cA + hstep, voffA);
        if (wr == 1) PG8_BAR;
        PG8_WAIT_V(4); PG8_BAR;
        PG8_STAGE(PG8_SB(1, 0), cB + kstep, voffB); PG8_STAGE(PG8_SA(1, 0), cA + kstep, voffA); PG8_STAGE(PG8_SB(1, 1), cB + hstep + kstep, voffB);
        PG8_WAIT_V(6); PG8_BAR;
    }
    for (;;) {
        const bool has_next = S.next(ui + 1, nxt);
        const char* nA = has_next ? (const char*)g.A + (size_t)nxt.pm * tstep : cA; const char* nB = has_next ? (const char*)g.Bt + (size_t)nxt.pn * tstep : cB;
        for (int t = 0; t < nt; t += 2) {
            const bool last = (t == nt - 2);
            const char* a1 = cA + (size_t)(t + 1) * kstep;
            const char* a2 = last ? nA : cA + (size_t)(t + 2) * kstep; const char* b2 = last ? nB : cB + (size_t)(t + 2) * kstep;
            const char* a3 = a2 + kstep; const char* b3 = b2 + kstep;
            if (last && has_next) S.a_ready(nxt);
            if constexpr (SP2) {
            PG8_LDB(B0, 0, 0); PG8_LDB(B1, 0, 1); PG8_SCHED; PG8_LDA(At, 0, 0); PG8_STAGE(PG8_SA(1, 1), a1 + hstep, voffA);
            PG8_WAIT_V(8); PG8_WAIT_L(0); PG8_BAR; PG8_MMA(0, 0, At, B0); PG8_MMA(0, 1, At, B1); PG8_BAR; PG8_SCHED;
            PG8_LDA(At, 0, 1); PG8_STAGE(PG8_SB(0, 0), b2, voffB); PG8_STAGE(PG8_SB(0, 1), b2 + hstep, voffB); PG8_STAGE(PG8_SA(0, 0), a2, voffA);
            PG8_WAIT_V(8); PG8_WAIT_L(0); PG8_BAR; PG8_MMA(1, 0, At, B0); PG8_MMA(1, 1, At, B1); PG8_BAR; PG8_SCHED;
            PG8_LDB(B0, 1, 0); PG8_LDB(B1, 1, 1); PG8_SCHED; PG8_LDA(At, 1, 0); PG8_STAGE(PG8_SA(0, 1), a2 + hstep, voffA);
            PG8_WAIT_V(8); PG8_WAIT_L(0); PG8_BAR; PG8_MMA(0, 0, At, B0); PG8_MMA(0, 1, At, B1); PG8_BAR; PG8_SCHED;
            PG8_LDA(At, 1, 1); PG8_STAGE(PG8_SB(1, 0), b3, voffB); PG8_STAGE(PG8_SB(1, 1), b3 + hstep, voffB); PG8_STAGE(PG8_SA(1, 0), a3, voffA);
            PG8_WAIT_V(8); PG8_WAIT_L(0); PG8_BAR; PG8_MMA(1, 0, At, B0); PG8_MMA(1, 1, At, B1); PG8_BAR; PG8_SCHED;
            } else {
            PG8_LDB(B0, 0, 0); PG8_SCHED; PG8_LDA(At, 0, 0); PG8_STAGE(PG8_SA(1, 1), a1 + hstep, voffA);
            PG8_WAIT_L(8); PG8_BAR; PG8_WAIT_L(0); PG8_MMA(0, 0, At, B0); PG8_BAR; PG8_SCHED;
            PG8_LDB(B1, 0, 1); PG8_STAGE(PG8_SB(0, 0), b2, voffB);
            PG8_BAR; PG8_WAIT_L(0); PG8_MMA(0, 1, At, B1); PG8_BAR;
            PG8_LDA(At, 0, 1); PG8_STAGE(PG8_SA(0, 0), a2, voffA);
            PG8_BAR; PG8_WAIT_L(0); PG8_MMA(1, 0, At, B0); PG8_BAR; PG8_SCHED;
            PG8_STAGE(PG8_SB(0, 1), b2 + hstep, voffB);
            PG8_WAIT_V(6); PG8_BAR; PG8_MMA(1, 1, At, B1); PG8_BAR;
            PG8_LDB(B0, 1, 0); PG8_SCHED; PG8_LDA(At, 1, 0); PG8_STAGE(PG8_SA(0, 1), a2 + hstep, voffA);
            PG8_WAIT_L(8); PG8_BAR; PG8_WAIT_L(0); PG8_MMA(0, 0, At, B0); PG8_BAR; PG8_SCHED;
            PG8_LDB(B1, 1, 1); PG8_STAGE(PG8_SB(1, 0), b3, voffB);
            PG8_BAR; PG8_WAIT_L(0); PG8_MMA(0, 1, At, B1); PG8_BAR;
            PG8_LDA(At, 1, 1); PG8_STAGE(PG8_SA(1, 0), a3, voffA);
            PG8_BAR; PG8_WAIT_L(0); PG8_MMA(1, 0, At, B0); PG8_BAR; PG8_SCHED;
            PG8_STAGE(PG8_SB(1, 1), b3 + hstep, voffB);
            PG8_WAIT_V(6); PG8_BAR; PG8_MMA(1, 1, At, B1); PG8_BAR;
            }
        }
        if constexpr (ALIGN_EPI) { if (wr == 0) PG8_BAR; }
        if constexpr (!Epi::AFTER_DRAIN) { E(acc, cur, wr, wc, fr, fq); S.done(cur); }
        if (!has_next) break;
#pragma unroll
        for (int a = 0; a < 2; ++a)
#pragma unroll
            for (int b = 0; b < 2; ++b)
#pragma unroll
                for (int m = 0; m < 4; ++m)
#pragma unroll
                    for (int n = 0; n < 2; ++n) acc[a][b][m][n] = (f32x4){0.f, 0.f, 0.f, 0.f};
        cur = nxt; cA = nA; cB = nB; ++ui;
        if constexpr (ALIGN_EPI) { if (wr == 1) PG8_BAR; }
    }
    PG8_WAIT_V(0);
    if constexpr (!ALIGN_EPI) { if (wr == 0) PG8_BAR; }
    PG8_BAR;
    if constexpr (Epi::AFTER_DRAIN) { E.fused(acc, cur, wr, wc, fr, fq, lds, wid, lane); S.done(cur); }
#undef PG8_SA
#undef PG8_SB
#undef PG8_STAGE
#undef PG8_LDA
#undef PG8_LDB
#undef PG8_MMA
#undef PG8_WAIT_V
#undef PG8_WAIT_L
#undef PG8_BAR
#undef PG8_SCHED
}
}


#define GAS __attribute__((address_space(1)))
#define LAS __attribute__((address_space(3)))
typedef unsigned short bf16;
typedef unsigned v4u __attribute__((ext_vector_type(4)));
typedef float f32x4 __attribute__((ext_vector_type(4)));
typedef short bf16x8 __attribute__((ext_vector_type(8)));
typedef GAS unsigned gu32;
typedef GAS unsigned long long gu64;
#define RLX_AGENT __ATOMIC_RELAXED, __HIP_MEMORY_SCOPE_AGENT
#define LDS_WAIT() asm volatile("s_waitcnt lgkmcnt(0)" ::: "memory")
#define VM_WAIT() asm volatile("s_waitcnt vmcnt(0)" ::: "memory")
__device__ __forceinline__ unsigned long long rt() { return __builtin_amdgcn_s_memrealtime(); }
__device__ __forceinline__ unsigned f2bf(float f) { unsigned u = __builtin_bit_cast(unsigned, f); return (u + 0x7fffu + ((u >> 16) & 1u)) >> 16; }
__device__ __forceinline__ unsigned pk2(float lo, float hi) { return f2bf(lo) | (f2bf(hi) << 16); }

#define XB_TMO      128
#define XB_XCNT(j)  (256  + 64 * (j))
#define XB_XSUB(j)  (1280 + 64 * (j))
#define XB_XGEN(j)  (2304 + 64 * (j))
#define XB_TOP      3328
#define XB_TOPGEN   3392
#define XCD_BAR_WORDS 3456
#define XB_SPIN_CAP (1u << 18)

__device__ __forceinline__ unsigned xb_ld(unsigned* p)              { return __hip_atomic_load(p, __ATOMIC_RELAXED, __HIP_MEMORY_SCOPE_AGENT); }
__device__ __forceinline__ unsigned xb_add(unsigned* p, unsigned v) { return __hip_atomic_fetch_add(p, v, __ATOMIC_RELAXED, __HIP_MEMORY_SCOPE_AGENT); }
__device__ __forceinline__ unsigned xb_xcc_id() { return (unsigned)__builtin_amdgcn_s_getreg((3 << 11) | 20) & 0xFu; }
#define XB_SPIN(cond, bar) do { unsigned _sp = 0; while (cond) { __builtin_amdgcn_s_sleep(1); \
    if ((++_sp & 255u) == 0u) { if (xb_ld(&(bar)[XB_TMO])) break; if (_sp > XB_SPIN_CAP) { atomicAdd(&(bar)[XB_TMO], 1u); break; } } } } while (0)

struct XcdBarrier {
    unsigned* bar; unsigned x;
    volatile LAS unsigned* st;
};

__device__ __forceinline__ XcdBarrier xcd_barrier_post(unsigned* bar, volatile LAS unsigned* st) {
    XcdBarrier b; b.bar = bar; b.x = xb_xcc_id(); b.st = st;
    if (threadIdx.x == 0) (void)xb_add(&bar[XB_XCNT(b.x)], 1u);
    return b;
}
__device__ __forceinline__ void xcd_barrier_complete(unsigned* bar, unsigned x, unsigned& nloc, unsigned& nx) {
    const unsigned G = gridDim.x * gridDim.y * gridDim.z;
    unsigned sum, cnt, mine, sp = 0u;
    for (;;) {
        sum = 0u; cnt = 0u; mine = 0u;
#pragma unroll
        for (unsigned j = 0; j < 16; ++j) { const unsigned c = xb_ld(&bar[XB_XCNT(j)]); sum += c; cnt += (c > 0u) ? 1u : 0u; mine = (j == x) ? c : mine; }
        if (sum == G) break;
        __builtin_amdgcn_s_sleep(1);
        if ((++sp & 255u) == 0u) { if (xb_ld(&bar[XB_TMO])) break; if (sp > XB_SPIN_CAP) { atomicAdd(&bar[XB_TMO], 1u); break; } }
    }
    nloc = mine > 0u ? mine : 1u; nx = cnt > 0u ? cnt : 1u;
}

__device__ __forceinline__ void xcd_barrier(const XcdBarrier& b) {
    asm volatile("s_waitcnt vmcnt(0)" ::: "memory");
    __syncthreads();
    if (threadIdx.x == 0) {
        unsigned* bar = b.bar;
        __builtin_amdgcn_s_waitcnt(0);
        unsigned nloc = b.st[0], nx = b.st[1];
        if (nloc == 0u) { xcd_barrier_complete(bar, b.x, nloc, nx); b.st[0] = nloc; b.st[1] = nx; }
        const unsigned old = xb_add(&bar[XB_XSUB(b.x)], 1u);
        const unsigned gen = old / nloc;
        if (old + 1u == (gen + 1u) * nloc) {
            __builtin_amdgcn_fence(__ATOMIC_RELEASE, "agent");
            asm volatile("s_waitcnt vmcnt(0)" ::: "memory");
            const unsigned og = xb_add(&bar[XB_TOP], 1u);
            const unsigned tg = og / nx;
            if (og + 1u == (tg + 1u) * nx) xb_add(&bar[XB_TOPGEN], 1u);
            else XB_SPIN(xb_ld(&bar[XB_TOPGEN]) == tg, bar);
            __builtin_amdgcn_fence(__ATOMIC_ACQUIRE, "agent");
            xb_add(&bar[XB_XGEN(b.x)], 1u);
            asm volatile("s_waitcnt vmcnt(0)" ::: "memory");
        } else {
            XB_SPIN(xb_ld(&bar[XB_XGEN(b.x)]) == gen, bar);
            __builtin_amdgcn_fence(__ATOMIC_ACQUIRE, "agent");
            asm volatile("s_waitcnt vmcnt(0)" ::: "memory");
        }
    }
    __syncthreads();
}

typedef unsigned u32x2 __attribute__((ext_vector_type(2)));

__device__ __forceinline__ float wave_sum(float v) {
#pragma unroll
    for (int o = 1; o < 64; o <<= 1) v += __shfl_xor(v, o);
    return v;
}
__device__ __forceinline__ void p0_transpose_item(const float* W, int K, int N, bf16* WT, const float* kscale, LAS float* scr, int item, int lane) {
    const int nblk = N / 32, kb = item / nblk, nb = item % nblk, k0 = 64 * kb, n0 = 32 * nb;
    f32x4 wv[8];
#pragma unroll
    for (int i = 0; i < 8; ++i) wv[i] = *(const GAS f32x4*)(W + (size_t)(k0 + 8 * i + (lane >> 3)) * N + n0 + 4 * (lane & 7));
#pragma unroll
    for (int i = 0; i < 8; ++i) { const int kk = 8 * i + (lane >> 3); f32x4 v = wv[i]; if (kscale) v = v * kscale[k0 + kk]; LAS float* d = scr + kk * 33 + 4 * (lane & 7); d[0] = v.x; d[1] = v.y; d[2] = v.z; d[3] = v.w; }
    LDS_WAIT(); asm volatile("" ::: "memory");
    const int c = lane & 7;
#pragma unroll
    for (int j = 0; j < 4; ++j) { const int n = (lane >> 3) + 8 * j; const LAS float* s = scr + (8 * c) * 33 + n;
        v4u o; o.x = pk2(s[0 * 33], s[1 * 33]); o.y = pk2(s[2 * 33], s[3 * 33]); o.z = pk2(s[4 * 33], s[5 * 33]); o.w = pk2(s[6 * 33], s[7 * 33]);
        *(GAS v4u*)(WT + (size_t)(n0 + n) * K + k0 + 8 * c) = o; }
    LDS_WAIT(); asm volatile("" ::: "memory");
}
__device__ __forceinline__ void rms_row2_to_bf16(const float* xrow0, const float* xrow1, const float* g, bf16* orow0, bf16* orow1, int lane) {
    const GAS f32x4* xa = (const GAS f32x4*)xrow0 + lane; const GAS f32x4* xb = (const GAS f32x4*)xrow1 + lane; const GAS f32x4* gr = (const GAS f32x4*)g + lane;
    f32x4 va[4], vb[4]; float sa = 0.f, sb = 0.f;
#pragma unroll
    for (int j = 0; j < 4; ++j) { va[j] = xa[64 * j]; vb[j] = xb[64 * j]; }
#pragma unroll
    for (int j = 0; j < 4; ++j) { sa += (va[j].x * va[j].x + va[j].y * va[j].y) + (va[j].z * va[j].z + va[j].w * va[j].w); sb += (vb[j].x * vb[j].x + vb[j].y * vb[j].y) + (vb[j].z * vb[j].z + vb[j].w * vb[j].w); }
    const float ra = rsqrtf(wave_sum(sa) * (1.f / 1024.f) + 1e-6f), rb = rsqrtf(wave_sum(sb) * (1.f / 1024.f) + 1e-6f);
    GAS unsigned long long* oa = (GAS unsigned long long*)orow0 + lane; GAS unsigned long long* ob = (GAS unsigned long long*)orow1 + lane;
#pragma unroll
    for (int j = 0; j < 4; ++j) { const f32x4 gg = gr[64 * j];
        oa[64 * j] = (unsigned long long)pk2(va[j].x * ra * gg.x, va[j].y * ra * gg.y) | ((unsigned long long)pk2(va[j].z * ra * gg.z, va[j].w * ra * gg.w) << 32);
        ob[64 * j] = (unsigned long long)pk2(vb[j].x * rb * gg.x, vb[j].y * rb * gg.y) | ((unsigned long long)pk2(vb[j].z * rb * gg.z, vb[j].w * rb * gg.w) << 32); }
}
__device__ __forceinline__ void rms_row_to_bf16(const float* xrow, const float* g, bf16* orow, int lane) {
    const GAS f32x4* xr = (const GAS f32x4*)xrow + lane; const GAS f32x4* gr = (const GAS f32x4*)g + lane;
    f32x4 v[4]; float s = 0.f;
#pragma unroll
    for (int j = 0; j < 4; ++j) { v[j] = xr[64 * j]; s += (v[j].x * v[j].x + v[j].y * v[j].y) + (v[j].z * v[j].z + v[j].w * v[j].w); }
    const float rstd = rsqrtf(wave_sum(s) * (1.f / 1024.f) + 1e-6f);
    GAS unsigned long long* o8 = (GAS unsigned long long*)orow + lane;
#pragma unroll
    for (int j = 0; j < 4; ++j) { const f32x4 gg = gr[64 * j];
        o8[64 * j] = (unsigned long long)pk2(v[j].x * rstd * gg.x, v[j].y * rstd * gg.y) | ((unsigned long long)pk2(v[j].z * rstd * gg.z, v[j].w * rstd * gg.w) << 32); }
}
__device__ __forceinline__ void p0_meta_item(LAS unsigned char* lds, int item, const float* meta, const float* g1, const float* w_in, bf16* KA, bf16* VA, float* KRM, float* VRM, unsigned* KN, int tid) {
    const int lane = tid & 63, wid = tid >> 6;
    LAS float* um = (LAS float*)lds;
    LAS float* part = (LAS float*)(lds + 65536);
    for (int rr = 0; rr < 2; ++rr) { const int r = wid * 2 + rr; const float* xrow = meta + r * 1024;
        f32x4 v[4]; float s = 0.f;
#pragma unroll
        for (int j = 0; j < 4; ++j) { v[j] = *((const f32x4*)xrow + lane + 64 * j); s += (v[j].x * v[j].x + v[j].y * v[j].y) + (v[j].z * v[j].z + v[j].w * v[j].w); }
        const float rstd = rsqrtf(wave_sum(s) * (1.f / 1024.f) + 1e-6f);
#pragma unroll
        for (int j = 0; j < 4; ++j) { const f32x4 gg = *((const f32x4*)g1 + lane + 64 * j); f32x4 o = v[j] * rstd * gg; *((LAS f32x4*)(um + r * 1024) + lane + 64 * j) = o; } }
    __syncthreads();
    const int j0 = item * 64 + lane;
    const int wcol = j0 < 2048 ? 1024 + j0 : 4096 + (j0 - 2048);
    float acc[16];
#pragma unroll
    for (int r = 0; r < 16; ++r) acc[r] = 0.f;
    const int kbeg = wid * 128;
    for (int k0 = kbeg; k0 < kbeg + 128; k0 += 16) {
        float wv[16];
#pragma unroll
        for (int q = 0; q < 16; ++q) wv[q] = w_in[(size_t)(k0 + q) * DIN + wcol];
#pragma unroll
        for (int q4 = 0; q4 < 4; ++q4)
#pragma unroll
            for (int r = 0; r < 16; ++r) { const f32x4 uu = *(const LAS f32x4*)(um + r * 1024 + k0 + 4 * q4); acc[r] += uu.x * wv[4 * q4] + uu.y * wv[4 * q4 + 1] + uu.z * wv[4 * q4 + 2] + uu.w * wv[4 * q4 + 3]; }
    }
#pragma unroll
    for (int r = 0; r < 16; ++r) part[(wid * 16 + r) * 64 + lane] = acc[r];
    __syncthreads();
    for (int o = tid; o < 1024; o += 512) { const int r = o >> 6, l = o & 63; float s = 0.f;
#pragma unroll
        for (int w = 0; w < 8; ++w) s += part[(w * 16 + r) * 64 + l];
        const int j = item * 64 + l;
        { float q8 = (j < 1024) ? s * s : 0.f; q8 += __shfl_xor(q8, 1); q8 += __shfl_xor(q8, 2); q8 += __shfl_xor(q8, 4);
          if (j < 1024 && (l & 7) == 0) for (int b = 0; b < BATCH; ++b) atomicMax(KN + ((b * 8 + (j >> 7)) * 2 + ((j >> 6) & 1)) * 8 + ((j >> 3) & 7), __float_as_uint(q8)); }
        if (j < 2048) { bf16* dst = j < 1024 ? KA : VA; const int col = j & 1023; const bf16 hv = (bf16)f2bf(s);
            for (int b = 0; b < BATCH; ++b) dst[((size_t)(b * 8 + (col >> 7)) * KVROWS + 48 + r) * 128 + (col & 127)] = hv; }
        else if (j < 3072) KRM[r * 1024 + (j - 2048)] = s * 0.0625f;
        else VRM[r * 2048 + (j - 3072)] = s; }
    __syncthreads();
}

namespace att {
typedef float f32x16 __attribute__((ext_vector_type(16)));
typedef short s16x4 __attribute__((ext_vector_type(4)));
typedef short v4i16_t __attribute__((ext_vector_type(4)));
constexpr int SLOT = 32768, OFF_QT = 3 * SLOT, OFF_WS = RING_BYTES + 1024, XSTR = 528;
static_assert(OFF_QT + 32768 <= RING_BYTES && 4 * 32 * XSTR <= 3 * SLOT && OFF_WS + 8 * 256 <= LDS_BYTES, "attention LDS map");
__device__ __forceinline__ int crow(int r, int hi) { return (r & 3) + 8 * (r >> 2) + 4 * hi; }
__device__ __forceinline__ s16x4 vtr(const LAS unsigned char* p) { return __builtin_bit_cast(s16x4, __builtin_amdgcn_ds_read_tr16_b64_v4i16((LAS v4i16_t*)p)); }
__device__ __forceinline__ float swapmax(float m) { auto rr = __builtin_amdgcn_permlane32_swap(__float_as_uint(m), __float_as_uint(m), false, false); return fmaxf(__uint_as_float(rr[0]), __uint_as_float(rr[1])); }
__device__ __forceinline__ float swapsum(float m) { auto rr = __builtin_amdgcn_permlane32_swap(__float_as_uint(m), __float_as_uint(m), false, false); return __uint_as_float(rr[0]) + __uint_as_float(rr[1]); }
__device__ __forceinline__ void dma16(const bf16* g, LAS unsigned char* l) { __builtin_amdgcn_global_load_lds((const unsigned*)g, (LAS unsigned*)l, 16, 0, 0); }
#define ATT_WAIT_BAR(N) asm volatile("s_waitcnt vmcnt(" #N ") lgkmcnt(0)\n\ts_barrier" ::: "memory")

__device__ __forceinline__ void attn_unit(LAS unsigned char* lds, int b, int h, int qblk, const bf16* QA, const bf16* KA, const bf16* VA, bf16* YDA, float lam, const float* headg, float slope2, const int tid, const unsigned* KN) {
    const int lane = tid & 63, r32 = lane & 31, hi = lane >> 5, wid = __builtin_amdgcn_readfirstlane(tid >> 6), c = wid & 1, qg = wid >> 1;
    const bf16* KAb = KA + (size_t)(b * 8 + h) * KVROWS * 128; const bf16* VAb = VA + (size_t)(b * 8 + h) * KVROWS * 128;
    const int drow = 8 * wid + (lane >> 4), dsl = lane & 15;
    unsigned koff[2], voff[2];
#pragma unroll
    for (int i = 0; i < 2; ++i) { const int row = drow + 4 * i; koff[i] = (unsigned)(row * 128 + ((dsl ^ (row & 15)) * 8)); voff[i] = (unsigned)(row * 128 + ((((dsl >> 2) ^ (row & 3)) * 4 + (dsl & 3)) * 8)); }
#define ATT_DMA(t, slot) do { const unsigned toff_ = (unsigned)((64 + 64 * (t)) * 128); LAS unsigned char* sb_ = lds + (slot) * SLOT + wid * 2048; \
        dma16(KAb + (koff[0] + toff_), sb_); dma16(KAb + (koff[1] + toff_), sb_ + 1024); dma16(VAb + (voff[0] + toff_), sb_ + 16384); dma16(VAb + (voff[1] + toff_), sb_ + 16384 + 1024); } while (0)
    const int q_idx = 128 * qblk + 32 * qg + r32;
    const int t_hi = 2 * qblk + 1;
    {
        const bf16* QAb = QA + (size_t)(b * SEQ + 128 * qblk) * 1024 + h * 128;
#pragma unroll
        for (int i = 0; i < 4; ++i) { const int row = 16 * wid + 4 * i + (lane >> 4); dma16(QAb + (unsigned)(row * 1024 + ((dsl ^ (row & 15)) * 8)), lds + OFF_QT + wid * 4096 + i * 1024); }
    }
    int s0 = 0, s1 = 1, s2 = 2;
    ATT_DMA(t_hi, 0); ATT_DMA(t_hi - 1, 1);
    const int A16 = ((c * 8 + hi) ^ (r32 & 15)) * 16;
    const LAS unsigned char* qfp = lds + OFF_QT + (32 * qg + r32) * 256;
    const int q4 = (lane & 15) >> 2;
    int kxo[4], vxo[4];
#pragma unroll
    for (int d0 = 0; d0 < 4; ++d0) { kxo[d0] = r32 * 256 + (A16 ^ (d0 * 32)); vxo[d0] = 16384 + (4 * hi + q4) * 256 + ((q4 ^ d0) * 64) + ((lane >> 4) & 1) * 32 + (lane & 3) * 8; }
    f32x16 base0;
#pragma unroll
    for (int r = 0; r < 16; ++r) base0[r] = slope2 * (float)crow(r, hi);
    const float s32 = 32.f * slope2;
    f32x16 o[4];
#pragma unroll
    for (int d = 0; d < 4; ++d)
#pragma unroll
        for (int r = 0; r < 16; ++r) o[d][r] = 0.f;
    float mref = -1e30f, l = 0.f;
    LAS float* wsf = (LAS float*)(lds + OFF_WS) + wid * 64;
    LAS unsigned char* votes = lds + OFF_WS + 2048 + 128;
    ATT_WAIT_BAR(4);
    float bq;
    { float kn2 = 0.f;
#pragma unroll
      for (int p = 0; p < 8; ++p) kn2 += __uint_as_float(KN[((b * 8 + h) * 2 + c) * 8 + p]);
      float q2 = 0.f;
#pragma unroll
      for (int d0 = 0; d0 < 4; ++d0) { const bf16x8 qv = *(const LAS bf16x8*)(qfp + (A16 ^ (d0 * 32)));
#pragma unroll
          for (int e = 0; e < 8; ++e) { const float f = __uint_as_float((unsigned)(unsigned short)qv[e] << 16); q2 += f * f; } }
      q2 = swapsum(q2);
      bq = sqrtf(q2 * kn2 * 1.02f) + 63.f * slope2 + 136.f; }
    bool wdone = false;
    for (int t = t_hi; t >= -1; --t) {
        if (t - 2 >= -1) ATT_DMA(t - 2, s2);
        if (!wdone && __all(bq + slope2 * 64.f * (float)(t - t_hi) < mref)) wdone = true;
        if (lane == 0) votes[(t & 1) * 8 + wid] = wdone ? 1 : 0;
        const bool active = !wdone && !(qg < 2 && t == t_hi);
        if (active) {
            const LAS unsigned char* sb = lds + s0 * SLOT;
            const LAS unsigned char* kp[4]; const LAS unsigned char* vp[4];
#pragma unroll
            for (int d0 = 0; d0 < 4; ++d0) { kp[d0] = sb + kxo[d0]; vp[d0] = sb + vxo[d0]; }
            bf16x8 kf[8], qf[4];
#pragma unroll
            for (int d0 = 0; d0 < 4; ++d0) { qf[d0] = *(const LAS bf16x8*)(qfp + (A16 ^ (d0 * 32))); kf[2 * d0] = *(const LAS bf16x8*)(kp[d0]); kf[2 * d0 + 1] = *(const LAS bf16x8*)(kp[d0] + 8192); }
            s16x4 vl[4], vh[4];
#define ATT_VLOAD(i, slot) do { vl[slot] = vtr(vp[(i) & 3] + ((i) >> 2) * 4096); vh[slot] = vtr(vp[(i) & 3] + ((i) >> 2) * 4096 + 2048); } while (0)
            __builtin_amdgcn_sched_barrier(0);
            f32x16 p0 = base0, p1 = base0;
#pragma unroll
            for (int d0 = 0; d0 < 4; ++d0) { p0 = __builtin_amdgcn_mfma_f32_32x32x16_bf16(kf[2 * d0], qf[d0], p0, 0, 0, 0); p1 = __builtin_amdgcn_mfma_f32_32x32x16_bf16(kf[2 * d0 + 1], qf[d0], p1, 0, 0, 0); }
            __builtin_amdgcn_sched_barrier(0);
            ATT_VLOAD(0, 0); ATT_VLOAD(1, 1); ATT_VLOAD(2, 2); ATT_VLOAD(3, 3);
            __builtin_amdgcn_sched_barrier(0);
            if (t == -1 || 64 * t + 63 > 128 * qblk + 32 * qg) {
                const int kv0 = 64 * t + 4 * hi;
#pragma unroll
                for (int r = 0; r < 16; ++r) { const int kv = kv0 + (r & 3) + 8 * (r >> 2);
                    const bool v0 = (kv <= q_idx) && (t >= 0 || kv >= -16), v1 = (kv + 32 <= q_idx) && (t >= 0 || kv + 32 >= -16);
                    p0[r] = v0 ? p0[r] : -INFINITY; p1[r] = v1 ? p1[r] : -INFINITY; }
            }
            const float toffs = slope2 * 64.f * (float)(t - t_hi);
            float pm = p0[0], pm1 = p1[0];
#pragma unroll
            for (int r = 1; r < 16; ++r) { pm = fmaxf(pm, p0[r]); pm1 = fmaxf(pm1, p1[r]); }
            pm = swapmax(fmaxf(pm, pm1 + s32));
            const float cand = pm + toffs;
            if (__any(cand > mref + 8.0f)) {
                const float mnew = fmaxf(mref, cand), f = __builtin_amdgcn_exp2f(mref - mnew); l *= f; mref = mnew;
                if (hi == 0) wsf[r32] = f;
                float fr[16];
#pragma unroll
                for (int r = 0; r < 16; ++r) fr[r] = wsf[crow(r, hi)];
#pragma unroll
                for (int d = 0; d < 4; ++d)
#pragma unroll
                    for (int r = 0; r < 16; ++r) o[d][r] *= fr[r];
            }
            const float mrel = mref - toffs, mrel1 = mrel - s32;
            float sacc = 0.f;
#pragma unroll
            for (int r = 0; r < 16; ++r) { p0[r] = __builtin_amdgcn_exp2f(p0[r] - mrel); p1[r] = __builtin_amdgcn_exp2f(p1[r] - mrel1); sacc += p0[r] + p1[r]; }
            l += sacc;
            v4u pw[4];
#pragma unroll
            for (int q = 0; q < 4; ++q) { pw[0][q] = pg8::cvt_pk_bf16(p0[2 * q], p0[2 * q + 1]); pw[1][q] = pg8::cvt_pk_bf16(p0[8 + 2 * q], p0[9 + 2 * q]);
                pw[2][q] = pg8::cvt_pk_bf16(p1[2 * q], p1[2 * q + 1]); pw[3][q] = pg8::cvt_pk_bf16(p1[8 + 2 * q], p1[9 + 2 * q]); }
            __builtin_amdgcn_sched_barrier(0);
#pragma unroll
            for (int i = 0; i < 16; ++i) { const bf16x8 vf = (bf16x8){vl[i & 3][0], vl[i & 3][1], vl[i & 3][2], vl[i & 3][3], vh[i & 3][0], vh[i & 3][1], vh[i & 3][2], vh[i & 3][3]};
                o[i & 3] = __builtin_amdgcn_mfma_f32_32x32x16_bf16(__builtin_bit_cast(bf16x8, pw[i >> 2]), vf, o[i & 3], 0, 0, 0);
                if (i + 4 < 16) ATT_VLOAD(i + 4, i & 3);
                __builtin_amdgcn_sched_barrier(0); }
#undef ATT_VLOAD
        }
        if (t - 2 >= -1) ATT_WAIT_BAR(4); else ATT_WAIT_BAR(0);
        { const int tmp = s0; s0 = s1; s1 = s2; s2 = tmp; }
        { const unsigned v0 = *(const LAS unsigned*)(votes + (t & 1) * 8), v1 = *(const LAS unsigned*)(votes + (t & 1) * 8 + 4); if (v0 == 0x01010101u && v1 == 0x01010101u) break; }
    }
    ATT_WAIT_BAR(0);
#undef ATT_DMA
    l = swapsum(l);
    if (hi == 0) wsf[32 + r32] = l;
    float rli[16];
#pragma unroll
    for (int r = 0; r < 16; ++r) rli[r] = 1.0f / wsf[32 + crow(r, hi)];
#pragma unroll
    for (int d = 0; d < 4; ++d)
#pragma unroll
        for (int r = 0; r < 16; ++r) o[d][r] *= rli[r];
    LAS unsigned char* xb = lds + qg * 32 * XSTR;
    if (c == 1) {
#pragma unroll
        for (int d = 0; d < 4; ++d)
#pragma unroll
            for (int r = 0; r < 16; ++r) *(LAS float*)(xb + crow(r, hi) * XSTR + (32 * d + r32) * 4) = o[d][r];
    }
    __syncthreads();
    if (c == 0) {
#pragma unroll
        for (int d = 0; d < 4; ++d)
#pragma unroll
            for (int r = 0; r < 16; ++r) { LAS float* p = (LAS float*)(xb + crow(r, hi) * XSTR + (32 * d + r32) * 4); *p = o[d][r] - lam * *p; }
        asm volatile("s_waitcnt lgkmcnt(0)" ::: "memory");
        int le = lane; asm volatile("" : "+v"(le));
        const int row = le >> 1, ch = le & 1;
        const LAS pg8::f32x4* rp = (const LAS pg8::f32x4*)(xb + row * XSTR + ch * 256);
        pg8::f32x4 v[16]; float ss = 0.f;
#pragma unroll
        for (int j = 0; j < 16; ++j) { v[j] = rp[j]; ss += (v[j][0] * v[j][0] + v[j][1] * v[j][1]) + (v[j][2] * v[j][2] + v[j][3] * v[j][3]); }
        ss += __shfl_xor(ss, 1);
        const float sc = rsqrtf(ss * (1.0f / 128.0f) + 1e-6f) * 0.8f;
        const pg8::f32x4* gp = (const pg8::f32x4*)(headg + (unsigned)(ch * 64));
        bf16* yp = YDA + (size_t)(b * SEQ + 128 * qblk + 32 * qg) * 1024 + h * 128 + (unsigned)(row * 1024 + ch * 64);
#pragma unroll
        for (int j = 0; j < 8; ++j) { const pg8::f32x4 g0 = gp[2 * j], g1 = gp[2 * j + 1]; *(v4u*)(yp + 8 * j) = pg8::pack8(v[2 * j] * g0 * sc, v[2 * j + 1] * g1 * sc); }
    }
    __syncthreads();
}
}

namespace ret {
using att::f32x16; using att::s16x4; using att::vtr; using att::crow;
constexpr int QSTR = 272, VPSTR = 144, STSTR = 528;
constexpr int OFF_Q = 0, OFF_KH = 128 * QSTR, OFF_VP = 2 * 128 * QSTR, OFF_ST = OFF_VP + 128 * VPSTR, LDS_END = OFF_ST + 64 * STSTR;
static_assert(LDS_END <= RING_BYTES, "retention LDS map");

template <int HF>
__device__ __forceinline__ void compute_half(LAS unsigned char* lds, int wid, int lane, f32x16& X0, f32x16& X1, f32x16& Cacc, f32x16& S, float g128) {
    const int r32 = lane & 31, hi = lane >> 5;
    { const int kb = wid & 3, qbp = wid >> 2; const bool need0 = kb <= 2 * qbp, need1 = kb <= 2 * qbp + 1;
      if (need1) {
        const LAS unsigned char* kp = lds + OFF_KH + (32 * kb + r32) * QSTR + hi * 16;
        const LAS unsigned char* q0 = lds + OFF_Q + (64 * qbp + r32) * QSTR + hi * 16;
#pragma unroll
        for (int ks = 0; ks < 8; ++ks) { const bf16x8 ka = *(const LAS bf16x8*)(kp + ks * 32);
            if (need0) { const bf16x8 qf = *(const LAS bf16x8*)(q0 + ks * 32); X0 = __builtin_amdgcn_mfma_f32_32x32x16_bf16(ka, qf, X0, 0, 0, 0); }
            const bf16x8 qf1 = *(const LAS bf16x8*)(q0 + 32 * QSTR + ks * 32); X1 = __builtin_amdgcn_mfma_f32_32x32x16_bf16(ka, qf1, X1, 0, 0, 0); }
      } }
    const int qb = wid >> 1, eb = wid & 1;
    { const LAS unsigned char* qp = lds + OFF_Q + (32 * qb + r32) * QSTR + hi * 16;
      const LAS unsigned char* sp = lds + OFF_ST + (32 * eb + r32) * STSTR + HF * 256 + hi * 16;
#pragma unroll
      for (int ks = 0; ks < 8; ++ks) { const bf16x8 qa = *(const LAS bf16x8*)(qp + ks * 32), sb = *(const LAS bf16x8*)(sp + ks * 32);
          Cacc = __builtin_amdgcn_mfma_f32_32x32x16_bf16(qa, sb, Cacc, 0, 0, 0); } }
    { const int dkl = wid >> 1, q4 = (lane & 15) >> 2, g1 = (lane >> 4) & 1, p = lane & 3;
#pragma unroll
      for (int r = 0; r < 16; ++r) S[r] *= g128;
      const LAS unsigned char* kt = lds + OFF_KH + (4 * q4 + 2 * hi) * QSTR + (32 * dkl + 16 * g1 + 4 * p) * 2;
      const LAS unsigned char* vt = lds + OFF_VP + (4 * q4 + 2 * hi) * VPSTR + (32 * eb + 16 * g1 + 4 * p) * 2;
#pragma unroll
      for (int ks = 0; ks < 8; ++ks) { const s16x4 a0 = vtr(kt + ks * 16 * QSTR), a1 = vtr(kt + ks * 16 * QSTR + QSTR), b0 = vtr(vt + ks * 16 * VPSTR), b1 = vtr(vt + ks * 16 * VPSTR + VPSTR);
          const bf16x8 af = (bf16x8){a0[0], a0[1], a0[2], a0[3], a1[0], a1[1], a1[2], a1[3]}, bfr = (bf16x8){b0[0], b0[1], b0[2], b0[3], b1[0], b1[1], b1[2], b1[3]};
          S = __builtin_amdgcn_mfma_f32_32x32x16_bf16(af, bfr, S, 0, 0, 0); } }
}
__device__ __forceinline__ void write_st(LAS unsigned char* lds, int dkb, int eb, int lane, const f32x16& S) {
    const int r32 = lane & 31, hi = lane >> 5; LAS unsigned char* p = lds + OFF_ST + (32 * eb + r32) * STSTR + (32 * dkb + 4 * hi) * 2;
#pragma unroll
    for (int g = 0; g < 4; ++g) { u32x2 w; w.x = pg8::cvt_pk_bf16(S[4 * g], S[4 * g + 1]); w.y = pg8::cvt_pk_bf16(S[4 * g + 2], S[4 * g + 3]); *(LAS u32x2*)(p + g * 16) = w; }
}
__device__ __forceinline__ void write_a(LAS unsigned char* lds, int kb, int qb, int lane, const f32x16& X) {
    const int r32 = lane & 31, hi = lane >> 5, q = 32 * qb + r32; LAS unsigned char* p = lds + OFF_Q + q * QSTR + (32 * kb + 4 * hi) * 2;
#pragma unroll
    for (int g = 0; g < 4; ++g) { const int k = 32 * kb + 8 * g + 4 * hi; float v[4];
#pragma unroll
        for (int j = 0; j < 4; ++j) v[j] = (k + j <= q) ? X[4 * g + j] : 0.f;
        u32x2 w; w.x = pg8::cvt_pk_bf16(v[0], v[1]); w.y = pg8::cvt_pk_bf16(v[2], v[3]); *(LAS u32x2*)(p + g * 16) = w; }
}

__device__ __forceinline__ void ret_item(LAS unsigned char* lds, int b, int h, int sl, const bf16* QR, const bf16* KR, bf16* VR, const float* KRM, const float* VRM, float* SS, const int tid) {
    const int lane = tid & 63, r32 = lane & 31, hi = lane >> 5, wid = __builtin_amdgcn_readfirstlane(tid >> 6);
    const float lg = log2f(1.0f - exp2f(-5.0f - (float)h));
    const float g128 = exp2f(128.f * lg);
    const int qb = wid >> 1, eb = wid & 1, dkl = wid >> 1;
    f32x16 S0, S1;
#pragma unroll
    for (int r = 0; r < 16; ++r) { S0[r] = 0.f; S1[r] = 0.f; }
    for (int m = 0; m < NMETA; ++m) { const float dm = exp2f(lg * (float)(15 - m)), vv = VRM[m * 2048 + h * 512 + sl * 64 + 32 * eb + r32] * dm; const float* kr = KRM + m * 1024 + h * 256 + 32 * dkl;
#pragma unroll
        for (int r = 0; r < 16; ++r) { S0[r] += kr[crow(r, hi)] * vv; S1[r] += kr[128 + crow(r, hi)] * vv; } }
    write_st(lds, dkl, eb, lane, S0); write_st(lds, 4 + dkl, eb, lane, S1);
    const int srow = tid >> 4, sch = tid & 15;
    const int vrow = tid >> 3, vch = tid & 7;
    const size_t rowb = (size_t)b * SEQ;
    const bf16* qsrc = QR + (rowb + srow) * 1024 + h * 256 + sch * 8;
    const bf16* ksrc = KR + (rowb + srow) * 1024 + h * 256 + sch * 8;
    bf16* vsrc = VR + (rowb + vrow) * 2048 + h * 512 + sl * 64 + vch * 8;
    LAS unsigned char* qdst = lds + OFF_Q + srow * QSTR + sch * 16;
    LAS unsigned char* kdst = lds + OFF_KH + srow * QSTR + sch * 16;
    LAS unsigned char* vdst = lds + OFF_VP + vrow * VPSTR + vch * 16;
    float vsc[2];
#pragma unroll
    for (int i = 0; i < 2; ++i) vsc[i] = exp2f(lg * (float)(127 - (vrow + 64 * i)));
    v4u qreg[4], kreg[4], vreg[2];
#pragma unroll
    for (int i = 0; i < 4; ++i) { qreg[i] = *(const v4u*)(qsrc + (size_t)i * 32 * 1024); kreg[i] = *(const v4u*)(ksrc + (size_t)i * 32 * 1024); }
#pragma unroll
    for (int i = 0; i < 2; ++i) vreg[i] = *(const v4u*)(vsrc + (size_t)i * 64 * 2048);
    f32x16 X0, X1, Cacc, T;
#pragma unroll
    for (int r = 0; r < 16; ++r) { X0[r] = 0.f; X1[r] = 0.f; Cacc[r] = 0.f; T[r] = 0.f; }
    for (int c = 0; c < 32; ++c) {
        const size_t coff = (size_t)c * 128;
#pragma unroll
        for (int i = 0; i < 4; ++i) { *(LAS v4u*)(qdst + i * 32 * QSTR) = qreg[i]; *(LAS v4u*)(kdst + i * 32 * QSTR) = kreg[i]; }
#pragma unroll
        for (int i = 0; i < 2; ++i) { pg8::f32x4 a, bq; pg8::unpack8(vreg[i], a, bq); *(LAS v4u*)(vdst + i * 64 * VPSTR) = pg8::pack8(a * vsc[i], bq * vsc[i]); }
#pragma unroll
        for (int i = 0; i < 4; ++i) { qreg[i] = *(const v4u*)(qsrc + (coff + i * 32) * 1024 + 128); kreg[i] = *(const v4u*)(ksrc + (coff + i * 32) * 1024 + 128); }
        __syncthreads();
        compute_half<0>(lds, wid, lane, X0, X1, Cacc, S0, g128);
        __syncthreads();
#pragma unroll
        for (int i = 0; i < 4; ++i) { *(LAS v4u*)(qdst + i * 32 * QSTR) = qreg[i]; *(LAS v4u*)(kdst + i * 32 * QSTR) = kreg[i]; }
        write_st(lds, dkl, eb, lane, S0);
        if (c + 1 < 32) {
#pragma unroll
            for (int i = 0; i < 4; ++i) { qreg[i] = *(const v4u*)(qsrc + (coff + 128 + i * 32) * 1024); kreg[i] = *(const v4u*)(ksrc + (coff + 128 + i * 32) * 1024); }
#pragma unroll
            for (int i = 0; i < 2; ++i) vreg[i] = *(const v4u*)(vsrc + (coff + 128 + i * 64) * 2048);
        }
        __syncthreads();
        compute_half<1>(lds, wid, lane, X0, X1, Cacc, S1, g128);
        __syncthreads();
        write_st(lds, 4 + dkl, eb, lane, S1);
        { const int kb = wid & 3, qbp = wid >> 2;
          if (kb <= 2 * qbp) write_a(lds, kb, 2 * qbp, lane, X0);
          if (kb <= 2 * qbp + 1) write_a(lds, kb, 2 * qbp + 1, lane, X1); }
        __syncthreads();
        { const int q4 = (lane & 15) >> 2, g1 = (lane >> 4) & 1, p = lane & 3;
          const LAS unsigned char* ap = lds + OFF_Q + (32 * qb + r32) * QSTR + hi * 16;
          const LAS unsigned char* vp = lds + OFF_VP + (8 * hi + q4) * VPSTR + (32 * eb + 16 * g1 + 4 * p) * 2;
#pragma unroll
          for (int kb = 0; kb < 4; ++kb) if (kb <= qb) {
#pragma unroll
              for (int s = 0; s < 2; ++s) { const bf16x8 af = *(const LAS bf16x8*)(ap + (32 * kb + 16 * s) * 2);
                  const s16x4 lo = vtr(vp + (32 * kb + 16 * s) * VPSTR), hh = vtr(vp + (32 * kb + 16 * s + 4) * VPSTR);
                  const bf16x8 vf = (bf16x8){lo[0], lo[1], lo[2], lo[3], hh[0], hh[1], hh[2], hh[3]};
                  T = __builtin_amdgcn_mfma_f32_32x32x16_bf16(af, vf, T, 0, 0, 0); } }
          bf16* op = VR + (rowb + coff + 32 * qb) * 2048 + h * 512 + sl * 64 + 32 * eb + r32;
          float* ssp = SS + (rowb + coff + 32 * qb) * 64 + h * 16 + sl * 2 + eb;
          float lgc = lg; asm volatile("" : "+v"(lgc));
#pragma unroll
          for (int r = 0; r < 16; ++r) { const float qf = (float)(32 * qb + crow(r, hi)); const float v = __builtin_amdgcn_exp2f(lgc * (qf - 127.f)) * T[r] + __builtin_amdgcn_exp2f(lgc * (qf + 1.f)) * Cacc[r]; op[(size_t)crow(r, hi) * 2048] = (bf16)f2bf(v);
              float s = v * v; s += __shfl_xor(s, 1); s += __shfl_xor(s, 2); s += __shfl_xor(s, 4); s += __shfl_xor(s, 8); s += __shfl_xor(s, 16);
              if (r32 == 0) ssp[(size_t)crow(r, hi) * 64] = s; }
#pragma unroll
          for (int r = 0; r < 16; ++r) { X0[r] = 0.f; X1[r] = 0.f; Cacc[r] = 0.f; T[r] = 0.f; } }
        __syncthreads();
    }
}
}

#ifndef MK_N_LAUNCHES
#define MK_N_LAUNCHES 1
#endif
constexpr int NPH = 11;
struct Args { const float* in[16]; float* out; unsigned char* ws; int ph_lo, ph_hi, dry, pad; };
__global__ void __launch_bounds__(NWAVES * 64, 2) fwd(Args args) {
    extern __shared__ __attribute__((aligned(16))) unsigned char lds_raw[];
    LAS unsigned char* lds = (LAS unsigned char*)lds_raw;
    volatile LAS unsigned* MISC = (volatile LAS unsigned*)(lds + MISC_OFF);
    const int wave = __builtin_amdgcn_readfirstlane(threadIdx.x >> 6);
#define PHASE_TID const int tid = threadIdx.x; int lane = tid; asm volatile("" : "+v"(lane)); lane &= 63; (void)lane;
    const int G = gridDim.x, bx = blockIdx.x, vcu = (G % 8 == 0) ? (bx % 8) * (G / 8) + bx / 8 : bx;
    typedef __attribute__((address_space(4))) const unsigned char* karg_t;
    karg_t kp0 = (karg_t)__builtin_amdgcn_kernarg_segment_ptr();
#define KARG_IN(i) (*(const float* __attribute__((address_space(4))) const*)(kp + 8 * (i)))
#define PHASE_PTRS \
    karg_t kp = kp0; asm volatile("" : "+s"(kp)); \
    float* out = *(float* __attribute__((address_space(4))) const*)(kp + 128); unsigned char* ws = *(unsigned char* __attribute__((address_space(4))) const*)(kp + 136); \
    bf16* QA = (bf16*)out; (void)QA; (void)ws; PHASE_TID
    gu32* ctl = (gu32*)(args.ws + WS_CTL);
    for (int u = threadIdx.x; u < (LDS_BYTES - LDSCTL_OFF) / 4; u += NWAVES * 64) ((LAS unsigned*)(lds + LDSCTL_OFF))[u] = 0u;
    __syncthreads();
    const int lo = args.ph_lo, hi = args.ph_hi;
    XcdBarrier bar; bar.bar = (unsigned*)(ctl + CW_BAR); bar.x = 0; bar.st = nullptr;
    if (hi - lo > 1) bar = xcd_barrier_post((unsigned*)(ctl + CW_BAR), MISC + 8);
#ifdef ONLY_PHASE
#define IN(k) ((k) == ONLY_PHASE && lo <= (k) && (k) < hi)
#else
#define IN(k) (lo <= (k) && (k) < hi)
#endif
#define SEAM(k) do { if (IN(k) && IN((k) + 1)) xcd_barrier(bar); } while (0)

    if (IN(0)) { PHASE_PTRS
        const float* x = KARG_IN(0); const float* meta = KARG_IN(1); const float* g1 = KARG_IN(2); const float* w_in = KARG_IN(3);
        const float* w_pa = KARG_IN(9); const float* w_pr = KARG_IN(10); const float* w_out = KARG_IN(11); const float* g2 = KARG_IN(12); const float* w_up = KARG_IN(13); const float* w_dn = KARG_IN(14);
        bf16* Win_t = (bf16*)(ws + WS_WIN); bf16* Wpa_t = (bf16*)(ws + WS_WPA); bf16* Wpr_t = (bf16*)(ws + WS_WPR); bf16* Wout_t = (bf16*)(ws + WS_WOUT); bf16* Wup_t = (bf16*)(ws + WS_WUP); bf16* Wdn_t = (bf16*)(ws + WS_WDN);
        bf16* U = (bf16*)(ws + WS_U); bf16* KA = (bf16*)(ws + WS_KA); bf16* VA = (bf16*)(ws + WS_VA); float* KRM = (float*)(ws + WS_KRM); float* VRM = (float*)(ws + WS_VRM);
        if (bx < 80) p0_meta_item(lds, bx, meta, g1, w_in, KA, VA, KRM, VRM, (unsigned*)(ws + WS_CTL) + CW_KN, tid);
        {
            const int gt = bx * 512 + tid;
            for (int i = gt; i < 2 * BATCH * 8 * 48 * 16; i += G * 512) { const int arr = i / (BATCH * 8 * 48 * 16), rem = i % (BATCH * 8 * 48 * 16), bh = rem / (48 * 16), r2 = rem % (48 * 16);
                bf16* dst = (arr ? VA : KA) + (size_t)bh * KVROWS * 128 + (size_t)r2 * 8; *(v4u*)dst = (v4u){0u, 0u, 0u, 0u}; } }
        LAS float* scr = (LAS float*)(lds + wave * 16384);
        const int gw = vcu * NWAVES + wave, NGW = G * NWAVES;
        constexpr int I_IN = 16 * (DIN / 32), I_PA = 16 * 32, I_PR = 32 * 32, I_OUT = 16 * 32, I_UP = 16 * (DFF / 32), I_DN = 64 * 32;
        constexpr int NITEMS = I_IN + I_PA + I_PR + I_OUT + I_UP + I_DN;
        for (int it = gw; it < NITEMS; it += NGW) {
            int r = it;
            if (r < I_IN) { p0_transpose_item(w_in, 1024, DIN, Win_t, nullptr, scr, r, lane); continue; } r -= I_IN;
            if (r < I_PA) { p0_transpose_item(w_pa, 1024, 1024, Wpa_t, nullptr, scr, r, lane); continue; } r -= I_PA;
            if (r < I_PR) { p0_transpose_item(w_pr, 2048, 1024, Wpr_t, nullptr, scr, r, lane); continue; } r -= I_PR;
            if (r < I_OUT) { p0_transpose_item(w_out, 1024, 1024, Wout_t, nullptr, scr, r, lane); continue; } r -= I_OUT;
            if (r < I_UP) { p0_transpose_item(w_up, 1024, DFF, Wup_t, g2, scr, r, lane); continue; } r -= I_UP;
            p0_transpose_item(w_dn, DFF, 1024, Wdn_t, nullptr, scr, r, lane);
        }
        for (int m = gw; m < MR; m += 2 * NGW) { const int m1 = m + NGW;
            if (m1 < MR) rms_row2_to_bf16(x + (size_t)m * 1024, x + (size_t)m1 * 1024, g1, U + (size_t)m * 1024, U + (size_t)m1 * 1024, lane);
            else rms_row_to_bf16(x + (size_t)m * 1024, g1, U + (size_t)m * 1024, lane); }
    }
    SEAM(0);
    if (IN(1)) { PHASE_PTRS bf16* U = (bf16*)(ws + WS_U); bf16* Win_t = (bf16*)(ws + WS_WIN);
        pg8::Gemm g{U, Win_t, MR, NQKV, 1024}; pg8::StaticOrder S; S.init(MR, NQKV, G, bx); pg8::EpiQKV E{QA, ws};
        pg8::gemm_phase<pg8::EpiQKV, pg8::StaticOrder, true, true>(lds, g, S, E, tid); }
    SEAM(1);
    if (IN(2)) { PHASE_PTRS bf16* KA = (bf16*)(ws + WS_KA); bf16* VA = (bf16*)(ws + WS_VA);
        float lam;
        { const float* lq1 = KARG_IN(4); const float* lk1 = KARG_IN(5); const float* lq2 = KARG_IN(6); const float* lk2 = KARG_IN(7); float s1 = 0.f, s2 = 0.f;
          for (int i = 0; i < 64; ++i) { s1 += lq1[i] * lk1[i]; s2 += lq2[i] * lk2[i]; }
          lam = expf(s1) - expf(s2) + 0.2f; }
        const float* headg = KARG_IN(8);
        const unsigned x0 = xb_xcc_id() & 7u;
        for (unsigned dx = 0; dx < 8; ++dx) { const unsigned xq = (x0 + dx) & 7u; gu32* qw = ctl + CW_QUEUE + 64 * xq;
            for (;;) {
                if (tid == 0) MISC[16] = __hip_atomic_fetch_add(qw, 1u, RLX_AGENT);
                __syncthreads();
                const unsigned u = MISC[16];
                if (u >= 256u) break;
                const int bh = (int)(xq * 8u + (u >> 5)), qblk = 31 - (int)(u & 31u), b = bh >> 3, h = bh & 7;
                const float slope2 = exp2f(-(float)(h + 1)) * 1.4426950408889634f;
                bf16* YD = QA + (args.dry ? (size_t)MR * 1024 : (size_t)0);
                att::attn_unit(lds, b, h, qblk, QA, KA, VA, YD, lam, headg, slope2, tid, (const unsigned*)(ws + WS_CTL) + CW_KN);
            }
            __syncthreads();
        }
    }
    SEAM(2);
    if (IN(3)) { PHASE_PTRS bf16* QR = (bf16*)(ws + WS_QR); bf16* KR = (bf16*)(ws + WS_KR); bf16* VR = (bf16*)(ws + WS_VR); float* KRM = (float*)(ws + WS_KRM); float* VRM = (float*)(ws + WS_VRM); float* SS = (float*)(ws + WS_SS);
        for (int it = vcu; it < 256; it += G) ret::ret_item(lds, it >> 5, (it >> 3) & 3, it & 7, QR, KR, VR, KRM, VRM, SS, tid); }
    SEAM(3);
    if (IN(4)) { PHASE_PTRS bf16* U = (bf16*)(ws + WS_U); bf16* Win_t = (bf16*)(ws + WS_WIN); float* SS = (float*)(ws + WS_SS);
        pg8::Gemm g{U, Win_t + (size_t)NQKV * 1024, MR, NGATE, 1024}; pg8::StaticOrder S; S.init(MR, NGATE, G, bx); pg8::EpiGates E{ws, SS};
        pg8::gemm_phase<pg8::EpiGates, pg8::StaticOrder, true, true>(lds, g, S, E, tid); }
    SEAM(4);
    if (IN(5)) { PHASE_PTRS bf16* Wpa_t = (bf16*)(ws + WS_WPA); bf16* SGA = (bf16*)(ws + WS_SGA); bf16* TMP = (bf16*)(ws + WS_TMP);
        pg8::Gemm g{QA, Wpa_t, MR, 1024, 1024}; pg8::StaticOrder S; S.init(MR, 1024, G, bx); pg8::EpiMergeA E{SGA, TMP};
        pg8::gemm_phase<pg8::EpiMergeA, pg8::StaticOrder, true, true>(lds, g, S, E, tid); }
    SEAM(5);
    if (IN(6)) { PHASE_PTRS bf16* VR = (bf16*)(ws + WS_VR); bf16* Wpr_t = (bf16*)(ws + WS_WPR); bf16* SGR = (bf16*)(ws + WS_SGR); bf16* TMP = (bf16*)(ws + WS_TMP); bf16* MRG = (bf16*)(ws + WS_MRG);
        pg8::Gemm g{VR, Wpr_t, MR, 1024, 2048}; pg8::StaticOrder S; S.init(MR, 1024, G, bx); pg8::EpiMergeB E{SGR, TMP, MRG};
        pg8::gemm_phase<pg8::EpiMergeB, pg8::StaticOrder, true, true>(lds, g, S, E, tid); }
    SEAM(6);
    if (IN(7)) { PHASE_PTRS const float* x = KARG_IN(0); bf16* MRG = (bf16*)(ws + WS_MRG); bf16* Wout_t = (bf16*)(ws + WS_WOUT); bf16* H1B = (bf16*)(ws + WS_H1B); float* SS2 = (float*)(ws + WS_SS2);
        pg8::Gemm g{MRG, Wout_t, MR, 1024, 1024}; pg8::StaticOrder S; S.init(MR, 1024, G, bx); pg8::EpiOut E{x, out, H1B, SS2};
        pg8::gemm_phase<pg8::EpiOut, pg8::StaticOrder, true, true>(lds, g, S, E, tid); }
    SEAM(7);
    if (IN(8)) { PHASE_PTRS bf16* H1B = (bf16*)(ws + WS_H1B); bf16* Wup_t = (bf16*)(ws + WS_WUP); float* SS2 = (float*)(ws + WS_SS2); bf16* HID = (bf16*)(ws + WS_HID);
        pg8::Gemm g{H1B, Wup_t, MR, DFF, 1024}; pg8::StaticOrder S; S.init(MR, DFF, G, bx); pg8::EpiUp E{SS2, HID};
        pg8::gemm_phase<pg8::EpiUp, pg8::StaticOrder, true, true>(lds, g, S, E, tid); }
    SEAM(8);
    if (IN(9)) { PHASE_PTRS bf16* HID = (bf16*)(ws + WS_HID); bf16* Wdn_t = (bf16*)(ws + WS_WDN);
        pg8::Gemm g{HID, Wdn_t, MR, 1024, DFF}; pg8::StaticOrder S; S.init(MR, 1024, G, bx); pg8::EpiDown E{out};
        pg8::gemm_phase<pg8::EpiDown, pg8::StaticOrder, true, true>(lds, g, S, E, tid); }
    SEAM(9);
    if (IN(10)) { PHASE_PTRS const float* gf = KARG_IN(15); const int gw = vcu * NWAVES + wave, NGW = G * NWAVES;
        const GAS f32x4* gr = (const GAS f32x4*)gf + lane;
        for (int m = gw; m < MR; m += 2 * NGW) { const int m1 = (m + NGW < MR) ? m + NGW : m;
            GAS f32x4* xa = (GAS f32x4*)(out + (size_t)m * 1024) + lane; GAS f32x4* xb = (GAS f32x4*)(out + (size_t)m1 * 1024) + lane;
            f32x4 va[4], vb[4]; float sa = 0.f, sb = 0.f;
#pragma unroll
            for (int j = 0; j < 4; ++j) { va[j] = xa[64 * j]; vb[j] = xb[64 * j]; }
#pragma unroll
            for (int j = 0; j < 4; ++j) { sa += (va[j].x * va[j].x + va[j].y * va[j].y) + (va[j].z * va[j].z + va[j].w * va[j].w); sb += (vb[j].x * vb[j].x + vb[j].y * vb[j].y) + (vb[j].z * vb[j].z + vb[j].w * vb[j].w); }
            const float ra = rsqrtf(wave_sum(sa) * (1.f / 1024.f) + 1e-6f), rb = rsqrtf(wave_sum(sb) * (1.f / 1024.f) + 1e-6f);
#pragma unroll
            for (int j = 0; j < 4; ++j) { const f32x4 gg = gr[64 * j]; xa[64 * j] = va[j] * ra * gg; if (m1 != m) xb[64 * j] = vb[j] * rb * gg; } } }
#undef IN
#undef SEAM
}

extern "C" void kernel_launch(void* const* d_in, const int* in_sizes, int n_in, void* d_out, int out_size, void* d_ws, size_t ws_size, hipStream_t stream) {
    static int grid = 0;
    if (grid == 0) {
        if (n_in != 16 || in_sizes[0] != MR * 1024 || out_size != MR * 1024 || ws_size < WS_END) { fprintf(stderr, "kernel_launch: unexpected shapes / workspace (n_in %d, in0 %d, out %d, ws %zu); nothing launched\n", n_in, n_in > 0 ? in_sizes[0] : -1, out_size, ws_size); grid = -1; return; }
        int dev = 0, cus = 0;
        if (hipGetDevice(&dev) != hipSuccess || hipDeviceGetAttribute(&cus, hipDeviceAttributeMultiprocessorCount, dev) != hipSuccess) { grid = -1; return; }
        if (hipFuncSetAttribute((const void*)fwd, hipFuncAttributeMaxDynamicSharedMemorySize, LDS_BYTES) != hipSuccess) { fprintf(stderr, "kernel_launch: hipFuncSetAttribute failed\n"); grid = -1; return; }
        (void)hipGetLastError();
        grid = cus;
    }
    if (grid < 0) return;
    (void)hipMemsetAsync((char*)d_ws + WS_CTL, 0, CTL_ZERO_BYTES, stream);
    Args a{};
    for (int i = 0; i < 16; ++i) a.in[i] = (const float*)d_in[i];
    a.out = (float*)d_out; a.ws = (unsigned char*)d_ws;
#if MK_N_LAUNCHES == 1
    a.ph_lo = 0; a.ph_hi = NPH; hipLaunchKernelGGL(fwd, dim3(grid), dim3(NWAVES * 64), LDS_BYTES, stream, a);
#else
    for (int ph = 0; ph < NPH; ++ph) { a.ph_lo = ph; a.ph_hi = ph + 1;
#if defined(PROBE_MASK)
        if ((PROBE_MASK >> ph) & 1) { a.dry = 1; hipLaunchKernelGGL(fwd, dim3(grid), dim3(NWAVES * 64), LDS_BYTES, stream, a); a.dry = 0; }
#endif
        hipLaunchKernelGGL(fwd, dim3(grid), dim3(NWAVES * 64), LDS_BYTES, stream, a); }
#endif
}
```

```cpp
#include <hip/hip_runtime.h>
#include <cstdio>
#include <cstdint>
constexpr int NWAVES = 8;
constexpr int BATCH = 8, SEQ = 4096, DM = 1024, NMETA = 16, MR = BATCH * SEQ;
constexpr int DIN = 11264, NQKV = 7168, NGATE = 4096, DFF = 4096;
constexpr int KVROWS = SEQ + 64;
constexpr size_t MiB = 1u << 20;
constexpr size_t WS_CTL = 0, CTL_ZERO_BYTES = 64 * 1024;
constexpr size_t WS_KRM = 1 * MiB;
constexpr size_t WS_VRM = WS_KRM + 64 * 1024;
constexpr size_t WS_SS = 2 * MiB;
constexpr size_t WS_SS2 = 10 * MiB;
constexpr size_t WS_WIN = 12 * MiB;
constexpr size_t WS_WPA = 34 * MiB, WS_WPR = 36 * MiB, WS_WOUT = 40 * MiB, WS_WUP = 42 * MiB, WS_WDN = 50 * MiB;
constexpr size_t WS_U = 58 * MiB;
constexpr size_t WS_QR = 122 * MiB, WS_KR = 186 * MiB;
constexpr size_t WS_VR = 250 * MiB;
constexpr size_t WS_KA = 378 * MiB, WS_VA = 443 * MiB;
constexpr size_t WS_END = 508 * MiB;
constexpr size_t WS_HID = WS_QR, WS_TMP = WS_KA, WS_H1B = WS_KA, WS_MRG = WS_U, WS_SGA = WS_QR, WS_SGR = WS_KR;
static_assert(WS_VA + (size_t)BATCH * KVROWS * 1024 * 2 <= WS_END && WS_TMP + (size_t)MR * 1024 * 4 <= WS_END && WS_HID + (size_t)MR * DFF * 2 <= WS_KA, "ws map");
constexpr int CW_BAR = 4096;
constexpr int CW_KN = 8192;
constexpr int CW_QUEUE = 1024;

constexpr int RING_BYTES = 131072, LDSCTL_OFF = RING_BYTES, MISC_OFF = LDSCTL_OFF + 320, LDS_BYTES = 147456;


namespace pg8 {
#define PG8_LAS __attribute__((address_space(3)))
typedef unsigned short bf16_t;
typedef short bf16x8 __attribute__((ext_vector_type(8)));
typedef float f32x4 __attribute__((ext_vector_type(4)));
typedef unsigned u32x4 __attribute__((ext_vector_type(4)));
typedef unsigned u32x2 __attribute__((ext_vector_type(2)));
constexpr int BM = 256, BK = 64, HALF = 128, HTB = HALF * BK * 2  , STAGE_BYTES = 8 * HTB, NXCD = 8, WGM = 8;

__host__ __device__ __forceinline__ int lds_byte(int r, int c) { const int st = (r >> 4) * 2 + (c >> 5), rr = r & 15, cc = c & 31, ob = rr * 64 + cc * 2; return st * 1024 + (ob ^ (((ob >> 9) & 1) << 5)); }
__host__ __device__ __forceinline__ void stage_rc(int b, int& R, int& C) { const int st = b / 1024, sb = b % 1024, swz = sb ^ (((sb >> 9) & 1) << 5); R = (st >> 1) * 16 + swz / 64; C = (st & 1) * 32 + (swz % 64) / 2; }
__host__ __device__ __forceinline__ int perm32(int rho) { const int n = rho >> 4, i = rho & 15; return 8 * (i >> 2) + 4 * n + (i & 3); }

struct Unit { int pm, pn; };
struct Gemm { const bf16_t* A; const bf16_t* Bt; int M, N, K; };

struct StaticOrder {
    int nM, nN, nwg, G, c;
    __host__ __device__ void init(int M, int N, int G_, int c_) { nM = M / BM; nN = N / BM; nwg = nM * nN; G = G_; c = c_; }
    __host__ __device__ bool next(int i, Unit& u) const {
        const long L = (long)i * G + c; if (L >= nwg) return false;
        int wgid = (int)L; { const int q = nwg / NXCD, r = nwg % NXCD, xcd = wgid % NXCD, off = wgid / NXCD; wgid = (xcd < r ? xcd * (q + 1) : r * (q + 1) + (xcd - r) * q) + off; }
        const int nig = WGM * nN, gid = wgid / nig, fm = gid * WGM, gsz = (nM - fm) < WGM ? (nM - fm) : WGM;
        u.pm = fm + ((wgid % nig) % gsz); u.pn = (wgid % nig) / gsz; return true;
    }
    __device__ __forceinline__ void a_ready(const Unit&) const {}
    __device__ __forceinline__ void done(const Unit&) const {}
};


typedef float f32x2_t __attribute__((ext_vector_type(2))); typedef __bf16 bf16x2_t __attribute__((ext_vector_type(2)));
__device__ __forceinline__ unsigned cvt_pk_bf16(float lo, float hi) { f32x2_t v = {lo, hi}; bf16x2_t b = __builtin_convertvector(v, bf16x2_t); return __builtin_bit_cast(unsigned, b); }
__device__ __forceinline__ u32x4 pack8(f32x4 a, f32x4 b) { u32x4 w; w.x = cvt_pk_bf16(a[0], a[1]); w.y = cvt_pk_bf16(a[2], a[3]); w.z = cvt_pk_bf16(b[0], b[1]); w.w = cvt_pk_bf16(b[2], b[3]); return w; }
__device__ __forceinline__ void unpack8(u32x4 w, f32x4& a, f32x4& b) {
    a[0] = __uint_as_float(w.x << 16); a[1] = __uint_as_float(w.x & 0xffff0000u); a[2] = __uint_as_float(w.y << 16); a[3] = __uint_as_float(w.y & 0xffff0000u);
    b[0] = __uint_as_float(w.z << 16); b[1] = __uint_as_float(w.z & 0xffff0000u); b[2] = __uint_as_float(w.w << 16); b[3] = __uint_as_float(w.w & 0xffff0000u); }
__device__ __forceinline__ float sigmoidf_(float g) { return __builtin_amdgcn_rcpf(1.0f + __builtin_amdgcn_exp2f(-1.4426950408889634f * g)); }
constexpr float QSCALE = 0.125f * 1.4426950408889634f;
constexpr float NEPS = 1e-6f;

struct EpiQKV {
    static constexpr bool PERM = true, AFTER_DRAIN = false;
    bf16_t* QA; unsigned char* ws;
    __device__ __forceinline__ void operator()(const f32x4 (&acc)[2][2][4][2], const Unit& u, int wr, int wc, int fr, int fq) const {
        const int pn = u.pn; const int row0 = u.pm * BM + wr * 64 + fr; int ldc = 1024; float sc = 1.f;
        const int grp = pn < 20 ? (pn >> 2) : 5, colt = (pn - 4 * grp) * 256;
        if (grp == 1 || grp == 2) {
            bf16_t* base = (bf16_t*)(ws + (grp == 1 ? WS_KA : WS_VA));
            const int b = (u.pm * BM) >> 12, srow = (row0 & 4095) + 64, hcol = wc * 32 + 8 * fq;
#pragma unroll
            for (int bj = 0; bj < 2; ++bj) { bf16_t* hb = base + ((size_t)(b * 8 + 2 * (pn & 3) + bj) * KVROWS + srow) * 128 + hcol; float mx = 0.f;
#pragma unroll
                for (int ai = 0; ai < 2; ++ai)
#pragma unroll
                    for (int m = 0; m < 4; ++m) { const f32x4 a0 = acc[ai][bj][m][0], a1 = acc[ai][bj][m][1]; *(u32x4*)(hb + (size_t)(ai * HALF + m * 16) * 128) = pack8(a0, a1);
                        mx = fmaxf(mx, (a0[0] * a0[0] + a0[1] * a0[1]) + (a0[2] * a0[2] + a0[3] * a0[3]) + (a1[0] * a1[0] + a1[1] * a1[1]) + (a1[2] * a1[2] + a1[3] * a1[3])); }
                if (grp == 1) {
                    mx = fmaxf(mx, __shfl_xor(mx, 1)); mx = fmaxf(mx, __shfl_xor(mx, 2)); mx = fmaxf(mx, __shfl_xor(mx, 4)); mx = fmaxf(mx, __shfl_xor(mx, 8));
                    if (fr == 0) atomicMax((unsigned*)(ws + WS_CTL) + CW_KN + ((b * 8 + 2 * (pn & 3) + bj) * 2 + (wc >> 1)) * 8 + ((wc & 1) * 4 + fq), __float_as_uint(mx)); } }
            return;
        }
        size_t boff = 0;
        if (grp == 0) sc = QSCALE;
        else if (grp == 3) boff = WS_QR;
        else if (grp == 4) { boff = WS_KR; sc = 0.0625f; }
        else { boff = WS_VR; ldc = 2048; }
        bf16_t* base = grp == 0 ? QA : (bf16_t*)(ws + boff);
        const int col0 = colt + wc * 32 + 8 * fq;
#pragma unroll
        for (int ai = 0; ai < 2; ++ai)
#pragma unroll
            for (int m = 0; m < 4; ++m) { bf16_t* rowp = base + (size_t)(row0 + ai * HALF + m * 16) * ldc + col0;
#pragma unroll
                for (int bj = 0; bj < 2; ++bj) *(u32x4*)(rowp + bj * HALF) = pack8(acc[ai][bj][m][0] * sc, acc[ai][bj][m][1] * sc); }
    }
};
struct EpiGates {
    static constexpr bool PERM = true, AFTER_DRAIN = false;
    unsigned char* ws; const float* SS;
    __device__ __forceinline__ void operator()(const f32x4 (&acc)[2][2][4][2], const Unit& u, int wr, int wc, int fr, int fq) const {
        const int pn = u.pn; const int row0 = u.pm * BM + wr * 64 + fr; const bool isy = pn < 8;
        const size_t boff = isy ? WS_VR : (pn < 12 ? WS_SGA : WS_SGR); bf16_t* base = (bf16_t*)(ws + boff); const int ldc = isy ? 2048 : 1024;
        const int col0 = (isy ? pn : (pn < 12 ? pn - 8 : pn - 12)) * 256 + wc * 32 + 8 * fq;
        const float* ssb = SS + (isy ? (pn >> 1) * 16 : 0);
#pragma unroll
        for (int ai = 0; ai < 2; ++ai)
#pragma unroll
            for (int m = 0; m < 4; ++m) { const int row = row0 + ai * HALF + m * 16; bf16_t* rowp = base + (size_t)row * ldc + col0;
                float rinv = 1.f;
                if (isy) { const f32x4* sp = (const f32x4*)(ssb + (size_t)row * 64); const f32x4 s4 = (sp[0] + sp[1]) + (sp[2] + sp[3]);
                    rinv = rsqrtf(((s4[0] + s4[1]) + (s4[2] + s4[3])) * (1.0f / 512.0f) + NEPS); }
#pragma unroll
                for (int bj = 0; bj < 2; ++bj) { f32x4 g0 = acc[ai][bj][m][0], g1 = acc[ai][bj][m][1];
#pragma unroll
                    for (int e = 0; e < 4; ++e) { g0[e] = sigmoidf_(g0[e]); g1[e] = sigmoidf_(g1[e]); }
                    if (isy) { f32x4 o0, o1; unpack8(*(const u32x4*)(rowp + bj * HALF), o0, o1); g0 = g0 * acc[ai][bj][m][0] * o0 * rinv; g1 = g1 * acc[ai][bj][m][1] * o1 * rinv; }
                    *(u32x4*)(rowp + bj * HALF) = pack8(g0, g1); }
                asm volatile("" ::: "memory"); }
    }
};
struct EpiMergeA {
    static constexpr bool PERM = true, AFTER_DRAIN = false;
    const bf16_t* SG; bf16_t* TMP;
    __device__ __forceinline__ void operator()(const f32x4 (&acc)[2][2][4][2], const Unit& u, int wr, int wc, int fr, int fq) const {
        const int row0 = u.pm * BM + wr * 64 + fr, col0 = u.pn * BM + wc * 32 + 8 * fq;
#pragma unroll
        for (int ai = 0; ai < 2; ++ai)
#pragma unroll
            for (int m = 0; m < 4; ++m)
#pragma unroll
                for (int bj = 0; bj < 2; ++bj) { const size_t off = (size_t)(row0 + ai * HALF + m * 16) * 1024 + col0 + bj * HALF; f32x4 s0, s1; unpack8(*(const u32x4*)(SG + off), s0, s1);
                    *(u32x4*)(TMP + off) = pack8(s0 * acc[ai][bj][m][0], s1 * acc[ai][bj][m][1]); }
    }
};
struct EpiMergeB {
    static constexpr bool PERM = true, AFTER_DRAIN = false;
    const bf16_t* SG; const bf16_t* TMP; bf16_t* MRG;
    __device__ __forceinline__ void operator()(const f32x4 (&acc)[2][2][4][2], const Unit& u, int wr, int wc, int fr, int fq) const {
        const int row0 = u.pm * BM + wr * 64 + fr, col0 = u.pn * BM + wc * 32 + 8 * fq;
#pragma unroll
        for (int ai = 0; ai < 2; ++ai)
#pragma unroll
            for (int m = 0; m < 4; ++m)
#pragma unroll
                for (int bj = 0; bj < 2; ++bj) { const size_t off = (size_t)(row0 + ai * HALF + m * 16) * 1024 + col0 + bj * HALF; f32x4 s0, s1; unpack8(*(const u32x4*)(SG + off), s0, s1);
                    f32x4 t0, t1; unpack8(*(const u32x4*)(TMP + off), t0, t1);
                    *(u32x4*)(MRG + off) = pack8(t0 + s0 * acc[ai][bj][m][0], t1 + s1 * acc[ai][bj][m][1]); }
    }
};
struct EpiOut {
    static constexpr bool PERM = true, AFTER_DRAIN = false;
    const float* X; float* H1; bf16_t* H1B; float* SS2;
    __device__ __forceinline__ void operator()(const f32x4 (&acc)[2][2][4][2], const Unit& u, int wr, int wc, int fr, int fq) const {
        const int row0 = u.pm * BM + wr * 64 + fr, col0 = u.pn * BM + wc * 32 + 8 * fq;
#pragma unroll
        for (int ai = 0; ai < 2; ++ai)
#pragma unroll
            for (int m = 0; m < 4; ++m) { const int row = row0 + ai * HALF + m * 16; float ss = 0.f;
#pragma unroll
                for (int bj = 0; bj < 2; ++bj) { const size_t off = (size_t)row * 1024 + col0 + bj * HALF;
                    const f32x4 h0 = *(const f32x4*)(X + off) + acc[ai][bj][m][0], h1 = *(const f32x4*)(X + off + 4) + acc[ai][bj][m][1];
                    *(f32x4*)(H1 + off) = h0; *(f32x4*)(H1 + off + 4) = h1; *(u32x4*)(H1B + off) = pack8(h0, h1);
                    ss += (h0[0] * h0[0] + h0[1] * h0[1]) + (h0[2] * h0[2] + h0[3] * h0[3]) + (h1[0] * h1[0] + h1[1] * h1[1]) + (h1[2] * h1[2] + h1[3] * h1[3]); }
                ss += __shfl_xor(ss, 16); ss += __shfl_xor(ss, 32);
                if (fq == 0) SS2[(size_t)row * 16 + u.pn * 4 + wc] = ss; }
    }
};
struct EpiUp {
    static constexpr bool PERM = true, AFTER_DRAIN = false;
    const float* SS2; bf16_t* HID;
    __device__ __forceinline__ void operator()(const f32x4 (&acc)[2][2][4][2], const Unit& u, int wr, int wc, int fr, int fq) const {
        const int row0 = u.pm * BM + wr * 64 + fr, col0 = u.pn * BM + wc * 32 + 8 * fq;
#pragma unroll
        for (int ai = 0; ai < 2; ++ai)
#pragma unroll
            for (int m = 0; m < 4; ++m) { const int row = row0 + ai * HALF + m * 16;
                const f32x4* sp = (const f32x4*)(SS2 + (size_t)row * 16); const f32x4 s4 = (sp[0] + sp[1]) + (sp[2] + sp[3]);
                const float rstd = rsqrtf(((s4[0] + s4[1]) + (s4[2] + s4[3])) * (1.0f / 1024.0f) + NEPS);
#pragma unroll
                for (int bj = 0; bj < 2; ++bj) { f32x4 v0 = acc[ai][bj][m][0] * rstd, v1 = acc[ai][bj][m][1] * rstd;
#pragma unroll
                    for (int e = 0; e < 4; ++e) { v0[e] = fmaxf(v0[e], 0.f); v0[e] *= v0[e]; v1[e] = fmaxf(v1[e], 0.f); v1[e] *= v1[e]; }
                    *(u32x4*)(HID + (size_t)row * 4096 + col0 + bj * HALF) = pack8(v0, v1); } }
    }
};
struct EpiDown {
    static constexpr bool PERM = true, AFTER_DRAIN = false;
    float* H;
    __device__ __forceinline__ void operator()(const f32x4 (&acc)[2][2][4][2], const Unit& u, int wr, int wc, int fr, int fq) const {
        const int row0 = u.pm * BM + wr * 64 + fr, col0 = u.pn * BM + wc * 32 + 8 * fq;
#pragma unroll
        for (int ai = 0; ai < 2; ++ai)
#pragma unroll
            for (int m = 0; m < 4; ++m)
#pragma unroll
                for (int bj = 0; bj < 2; ++bj) { float* p = H + (size_t)(row0 + ai * HALF + m * 16) * 1024 + col0 + bj * HALF;
                    const f32x4 h0 = *(const f32x4*)p + acc[ai][bj][m][0], h1 = *(const f32x4*)(p + 4) + acc[ai][bj][m][1]; *(f32x4*)p = h0; *(f32x4*)(p + 4) = h1; }
    }
};

template <class Epi, class Sched, bool ALIGN_EPI = false, bool SP2 = false>
__device__ __forceinline__ void gemm_phase(PG8_LAS unsigned char* lds, const Gemm g, const Sched& S, const Epi& E, const int tid) {
    const int wid = __builtin_amdgcn_readfirstlane(tid >> 6), lane = tid & 63, wr = wid >> 2, wc = wid & 3, fr = lane & 15, fq = lane >> 4;
    const int K = g.K, nt = K / BK;
    unsigned voffA[2], voffB[2];
#pragma unroll
    for (int i = 0; i < 2; ++i) { int R, C; stage_rc(tid * 16 + i * 8192, R, C); const int Rb = Epi::PERM ? ((R & ~31) + perm32(R & 31)) : R;
        voffA[i] = (unsigned)(R * K + C) * 2u; voffB[i] = (unsigned)(Rb * K + C) * 2u; }
    const size_t kstep = (size_t)(BK * 2);
    const size_t hstep = (size_t)HALF * K * 2;
    const size_t tstep = 2 * hstep;
    const unsigned ldsw = (unsigned)wid * 1024u;
    const int aoff = lds_byte(wr * 64 + fr, fq * 8), boff = lds_byte(wc * 32 + fr, fq * 8);
#define PG8_SA(b, h) (((b) * 2 + (h)) * HTB)
#define PG8_SB(b, h) ((4 + (b) * 2 + (h)) * HTB)
#define PG8_STAGE(bufoff, gbase, voff) do { _Pragma("unroll") for (int _i = 0; _i < 2; ++_i) \
        __builtin_amdgcn_global_load_lds((const unsigned*)((const char*)(gbase) + (voff)[_i]), (PG8_LAS unsigned*)(lds + (bufoff) + ldsw + _i * 8192), 16, 0, 0); } while (0)
#define PG8_LDA(dst, b, h) do { _Pragma("unroll") for (int m = 0; m < 4; ++m) _Pragma("unroll") for (int k = 0; k < 2; ++k) dst[m][k] = *(const PG8_LAS bf16x8*)(lds + PG8_SA(b, h) + aoff + m * 2048 + k * 1024); } while (0)
#define PG8_LDB(dst, b, h) do { _Pragma("unroll") for (int n = 0; n < 2; ++n) _Pragma("unroll") for (int k = 0; k < 2; ++k) dst[n][k] = *(const PG8_LAS bf16x8*)(lds + PG8_SB(b, h) + boff + n * 2048 + k * 1024); } while (0)
#define PG8_MMA(ai, bj, At, Bt) do { __builtin_amdgcn_s_setprio(1); _Pragma("unroll") for (int m = 0; m < 4; ++m) _Pragma("unroll") for (int n = 0; n < 2; ++n) _Pragma("unroll") for (int k = 0; k < 2; ++k) \
        acc[ai][bj][m][n] = __builtin_amdgcn_mfma_f32_16x16x32_bf16(Bt[n][k], At[m][k], acc[ai][bj][m][n], 0, 0, 0); __builtin_amdgcn_s_setprio(0); } while (0)
#define PG8_WAIT_V(n) asm volatile("s_waitcnt vmcnt(" #n ")" ::: "memory")
#define PG8_WAIT_L(n) asm volatile("s_waitcnt lgkmcnt(" #n ")" ::: "memory")
#define PG8_BAR __builtin_amdgcn_s_barrier()
#define PG8_SCHED __builtin_amdgcn_sched_barrier(0)
    Unit cur, nxt; int ui = 0;
    if (!S.next(0, cur)) return;
    f32x4 acc[2][2][4][2];
#pragma unroll
    for (int a = 0; a < 2; ++a)
#pragma unroll
        for (int b = 0; b < 2; ++b)
#pragma unroll
            for (int m = 0; m < 4; ++m)
#pragma unroll
                for (int n = 0; n < 2; ++n) acc[a][b][m][n] = (f32x4){0.f, 0.f, 0.f, 0.f};
    bf16x8 At[4][2], B0[2][2], B1[2][2];
    const char* cA = (const char*)g.A + (size_t)cur.pm * tstep; const char* cB = (const char*)g.Bt + (size_t)cur.pn * tstep;
    S.a_ready(cur);
    if constexpr (SP2) {
        PG8_STAGE(PG8_SB(0, 0), cB, voffB); PG8_STAGE(PG8_SB(0, 1), cB + hstep, voffB); PG8_STAGE(PG8_SA(0, 0), cA, voffA); PG8_STAGE(PG8_SA(0, 1), cA + hstep, voffA);
        if (wr == 1) PG8_BAR;
        PG8_WAIT_V(2); PG8_BAR;
        PG8_STAGE(PG8_SB(1, 0), cB + kstep, voffB); PG8_STAGE(PG8_SA(1, 0), cA + kstep, voffA); PG8_STAGE(PG8_SB(1, 1), cB + hstep + kstep, voffB);
        PG8_WAIT_V(6); PG8_BAR;
    } else {
        PG8_STAGE(PG8_SB(0, 0), cB, voffB); PG8_STAGE(PG8_SA(0, 0), cA, voffA); PG8_STAGE(PG8_SB(0, 1), cB + hstep, voffB); PG8_STAGE(PG8_SA(0, 1), cA + hstep, voffA);
        if (wr == 1) PG8_BAR;
        PG8_WAIT_V(4); PG8_BAR;
        PG8_STAGE(PG8_SB(1, 0), cB + kstep, voffB); PG8_STAGE(PG8_SA(1, 0), cA + kstep, voffA); PG8_STAGE(PG8_SB(1, 1), cB + hstep + kstep, voffB);
        PG8_WAIT_V(6); PG8_BAR;
    }
    for (;;) {
        const bool has_next = S.next(ui + 1, nxt);
        const char* nA = has_next ? (const char*)g.A + (size_t)nxt.pm * tstep : cA; const char* nB = has_next ? (const char*)g.Bt + (size_t)nxt.pn * tstep : cB;
        for (int t = 0; t < nt; t += 2) {
            const bool last = (t == nt - 2);
            const char* a1 = cA + (size_t)(t + 1) * kstep;
            const char* a2 = last ? nA : cA + (size_t)(t + 2) * kstep; const char* b2 = last ? nB : cB + (size_t)(t + 2) * kstep;
            const char* a3 = a2 + kstep; const char* b3 = b2 + kstep;
            if (last && has_next) S.a_ready(nxt);
            if constexpr (SP2) {
            PG8_LDB(B0, 0, 0); PG8_LDB(B1, 0, 1); PG8_SCHED; PG8_LDA(At, 0, 0); PG8_STAGE(PG8_SA(1, 1), a1 + hstep, voffA);
            PG8_WAIT_V(8); PG8_WAIT_L(0); PG8_BAR; PG8_MMA(0, 0, At, B0); PG8_MMA(0, 1, At, B1); PG8_BAR; PG8_SCHED;
            PG8_LDA(At, 0, 1); PG8_STAGE(PG8_SB(0, 0), b2, voffB); PG8_STAGE(PG8_SB(0, 1), b2 + hstep, voffB); PG8_STAGE(PG8_SA(0, 0), a2, voffA);
            PG8_WAIT_V(8); PG8_WAIT_L(0); PG8_BAR; PG8_MMA(1, 0, At, B0); PG8_MMA(1, 1, At, B1); PG8_BAR; PG8_SCHED;
            PG8_LDB(B0, 1, 0); PG8_LDB(B1, 1, 1); PG8_SCHED; PG8_LDA(At, 1, 0); PG8_STAGE(PG8_SA(0, 1), a2 + hstep, voffA);
            PG8_WAIT_V(8); PG8_WAIT_L(0); PG8_BAR; PG8_MMA(0, 0, At, B0); PG8_MMA(0, 1, At, B1); PG8_BAR; PG8_SCHED;
            PG8_LDA(At, 1, 1); PG8_STAGE(PG8_SB(1, 0), b3, voffB); PG8_STAGE(PG8_SB(1, 1), b3 + hstep, voffB); PG8_STAGE(PG8_SA(1, 0), a3, voffA);
            PG8_WAIT_V(8); PG8_WAIT_L(0); PG8_BAR; PG8_MMA(1, 0, At, B0); PG8_MMA(1, 1, At, B1); PG8_BAR; PG8_SCHED;
            } else {
            PG8_LDB(B0, 0, 0); PG8_SCHED; PG8_LDA(At, 0, 0); PG8_STAGE(PG8_SA(1, 1), a1 + hstep, voffA);
            PG8_WAIT_L(8); PG8_BAR; PG8_WAIT_L(0); PG8_MMA(0, 0, At, B0); PG8_BAR; PG8_SCHED;
            PG8_LDB(B1, 0, 1); PG8_STAGE(PG8_SB(0, 0), b2, voffB);
            PG8_BAR; PG8_WAIT_L(0); PG8_MMA(0, 1, At, B1); PG8_BAR;
            PG8_LDA(At, 0, 1); PG8_STAGE(PG8_SA(0, 0), a2, voffA);
            PG8_BAR; PG8_WAIT_L(0); PG8_MMA(1, 0, At, B0); PG8_BAR; PG8_SCHED;
            PG8_STAGE(PG8_SB(0, 1), b2 + hstep, voffB);
            PG8_WAIT_V(6); PG8_BAR; PG8_MMA(1, 1, At, B1); PG8_BAR;
            PG8_LDB(B0, 1, 0); PG8_SCHED; PG8_LDA(At, 1, 0); PG8_STAGE(PG8_SA(0, 1), a2 + hstep, voffA);
            PG8_WAIT_L(8); PG8_BAR; PG8_WAIT_L(0); PG8_MMA(0, 0, At, B0); PG8_BAR; PG8_SCHED;
            PG8_LDB(B1, 1, 1); PG8_STAGE(PG8_SB(1, 0), b3, voffB);
            PG8_BAR; PG8_WAIT_L(0); PG8_MMA(0, 1, At, B1); PG8_BAR;
            PG8_LDA(At, 1, 1); PG8_STAGE(PG8_SA(1, 0), a3, voffA);
            PG8_BAR; PG8_WAIT_L(0); PG8_MMA(1, 0, At, B0); PG8_BAR; PG8_SCHED;
            PG8_STAGE(PG8_SB(1, 1), b3 + hstep, voffB);
            PG8_WAIT_V(6); PG8_BAR; PG8_MMA(1, 1, At, B1); PG8_BAR;
            }
        }
        if constexpr (ALIGN_EPI) { if (wr == 0) PG8_BAR; }
        if constexpr (!Epi::AFTER_DRAIN) { E(acc, cur, wr, wc, fr, fq); S.done(cur); }
        if (!has_next) break;
#pragma unroll
        for (int a = 0; a < 2; ++a)
#pragma unroll
            for (int b = 0; b < 2; ++b)
#pragma unroll
                for (int m = 0; m < 4; ++m)
#pragma unroll
                    for (int n = 0; n < 2; ++n) acc[a][b][m][n] = (f32x4){0.f, 0.f, 0.f, 0.f};
        cur = nxt; cA = nA; cB = nB; ++ui;
        if constexpr (ALIGN_EPI) { if (wr == 1) PG8_BAR; }
    }
    PG8_WAIT_V(0);
    if constexpr (!ALIGN_EPI) { if (wr == 0) PG8_BAR; }
    PG8_BAR;
    if constexpr (Epi::AFTER_DRAIN) { E.fused(acc, cur, wr, wc, fr, fq, lds, wid, lane); S.done(cur); }
#undef PG8_SA
#undef PG8_SB
#undef PG8_STAGE
#undef PG8_LDA
#undef PG8_LDB
#undef PG8_MMA
#undef PG8_WAIT_V
#undef PG8_WAIT_L
#undef PG8_BAR
#undef PG8_SCHED
}
}


#define GAS __attribute__((address_space(1)))
#define LAS __attribute__((address_space(3)))
typedef unsigned short bf16;
typedef unsigned v4u __attribute__((ext_vector_type(4)));
typedef float f32x4 __attribute__((ext_vector_type(4)));
typedef short bf16x8 __attribute__((ext_vector_type(8)));
typedef GAS unsigned gu32;
typedef GAS unsigned long long gu64;
#define RLX_AGENT __ATOMIC_RELAXED, __HIP_MEMORY_SCOPE_AGENT
#define LDS_WAIT() asm volatile("s_waitcnt lgkmcnt(0)" ::: "memory")
#define VM_WAIT() asm volatile("s_waitcnt vmcnt(0)" ::: "memory")
__device__ __forceinline__ unsigned long long rt() { return __builtin_amdgcn_s_memrealtime(); }
__device__ __forceinline__ unsigned f2bf(float f) { unsigned u = __builtin_bit_cast(unsigned, f); return (u + 0x7fffu + ((u >> 16) & 1u)) >> 16; }
__device__ __forceinline__ unsigned pk2(float lo, float hi) { return f2bf(lo) | (f2bf(hi) << 16); }

#define XB_TMO      128
#define XB_XCNT(j)  (256  + 64 * (j))
#define XB_XSUB(j)  (1280 + 64 * (j))
#define XB_XGEN(j)  (2304 + 64 * (j))
#define XB_TOP      3328
#define XB_TOPGEN   3392
#define XCD_BAR_WORDS 3456
#define XB_SPIN_CAP (1u << 18)

__device__ __forceinline__ unsigned xb_ld(unsigned* p)              { return __hip_atomic_load(p, __ATOMIC_RELAXED, __HIP_MEMORY_SCOPE_AGENT); }
__device__ __forceinline__ unsigned xb_add(unsigned* p, unsigned v) { return __hip_atomic_fetch_add(p, v, __ATOMIC_RELAXED, __HIP_MEMORY_SCOPE_AGENT); }
__device__ __forceinline__ unsigned xb_xcc_id() { return (unsigned)__builtin_amdgcn_s_getreg((3 << 11) | 20) & 0xFu; }
#define XB_SPIN(cond, bar) do { unsigned _sp = 0; while (cond) { __builtin_amdgcn_s_sleep(1); \
    if ((++_sp & 255u) == 0u) { if (xb_ld(&(bar)[XB_TMO])) break; if (_sp > XB_SPIN_CAP) { atomicAdd(&(bar)[XB_TMO], 1u); break; } } } } while (0)

struct XcdBarrier {
    unsigned* bar; unsigned x;
    volatile LAS unsigned* st;
};

__device__ __forceinline__ XcdBarrier xcd_barrier_post(unsigned* bar, volatile LAS unsigned* st) {
    XcdBarrier b; b.bar = bar; b.x = xb_xcc_id(); b.st = st;
    if (threadIdx.x == 0) (void)xb_add(&bar[XB_XCNT(b.x)], 1u);
    return b;
}
__device__ __forceinline__ void xcd_barrier_complete(unsigned* bar, unsigned x, unsigned& nloc, unsigned& nx) {
    const unsigned G = gridDim.x * gridDim.y * gridDim.z;
    unsigned sum, cnt, mine, sp = 0u;
    for (;;) {
        sum = 0u; cnt = 0u; mine = 0u;
#pragma unroll
        for (unsigned j = 0; j < 16; ++j) { const unsigned c = xb_ld(&bar[XB_XCNT(j)]); sum += c; cnt += (c > 0u) ? 1u : 0u; mine = (j == x) ? c : mine; }
        if (sum == G) break;
        __builtin_amdgcn_s_sleep(1);
        if ((++sp & 255u) == 0u) { if (xb_ld(&bar[XB_TMO])) break; if (sp > XB_SPIN_CAP) { atomicAdd(&bar[XB_TMO], 1u); break; } }
    }
    nloc = mine > 0u ? mine : 1u; nx = cnt > 0u ? cnt : 1u;
}

__device__ __forceinline__ void xcd_barrier(const XcdBarrier& b) {
    asm volatile("s_waitcnt vmcnt(0)" ::: "memory");
    __syncthreads();
    if (threadIdx.x == 0) {
        unsigned* bar = b.bar;
        __builtin_amdgcn_s_waitcnt(0);
        unsigned nloc = b.st[0], nx = b.st[1];
        if (nloc == 0u) { xcd_barrier_complete(bar, b.x, nloc, nx); b.st[0] = nloc; b.st[1] = nx; }
        const unsigned old = xb_add(&bar[XB_XSUB(b.x)], 1u);
        const unsigned gen = old / nloc;
        if (old + 1u == (gen + 1u) * nloc) {
            __builtin_amdgcn_fence(__ATOMIC_RELEASE, "agent");
            asm volatile("s_waitcnt vmcnt(0)" ::: "memory");
            const unsigned og = xb_add(&bar[XB_TOP], 1u);
            const unsigned tg = og / nx;
            if (og + 1u == (tg + 1u) * nx) xb_add(&bar[XB_TOPGEN], 1u);
            else XB_SPIN(xb_ld(&bar[XB_TOPGEN]) == tg, bar);
            __builtin_amdgcn_fence(__ATOMIC_ACQUIRE, "agent");
            xb_add(&bar[XB_XGEN(b.x)], 1u);
            asm volatile("s_waitcnt vmcnt(0)" ::: "memory");
        } else {
            XB_SPIN(xb_ld(&bar[XB_XGEN(b.x)]) == gen, bar);
            __builtin_amdgcn_fence(__ATOMIC_ACQUIRE, "agent");
            asm volatile("s_waitcnt vmcnt(0)" ::: "memory");
        }
    }
    __syncthreads();
}

typedef unsigned u32x2 __attribute__((ext_vector_type(2)));

__device__ __forceinline__ float wave_sum(float v) {
#pragma unroll
    for (int o = 1; o < 64; o <<= 1) v += __shfl_xor(v, o);
    return v;
}
__device__ __forceinline__ void p0_transpose_item(const float* W, int K, int N, bf16* WT, const float* kscale, LAS float* scr, int item, int lane) {
    const int nblk = N / 32, kb = item / nblk, nb = item % nblk, k0 = 64 * kb, n0 = 32 * nb;
    f32x4 wv[8];
#pragma unroll
    for (int i = 0; i < 8; ++i) wv[i] = *(const GAS f32x4*)(W + (size_t)(k0 + 8 * i + (lane >> 3)) * N + n0 + 4 * (lane & 7));
#pragma unroll
    for (int i = 0; i < 8; ++i) { const int kk = 8 * i + (lane >> 3); f32x4 v = wv[i]; if (kscale) v = v * kscale[k0 + kk]; LAS float* d = scr + kk * 33 + 4 * (lane & 7); d[0] = v.x; d[1] = v.y; d[2] = v.z; d[3] = v.w; }
    LDS_WAIT(); asm volatile("" ::: "memory");
    const int c = lane & 7;
#pragma unroll
    for (int j = 0; j < 4; ++j) { const int n = (lane >> 3) + 8 * j; const LAS float* s = scr + (8 * c) * 33 + n;
        v4u o; o.x = pk2(s[0 * 33], s[1 * 33]); o.y = pk2(s[2 * 33], s[3 * 33]); o.z = pk2(s[4 * 33], s[5 * 33]); o.w = pk2(s[6 * 33], s[7 * 33]);
        *(GAS v4u*)(WT + (size_t)(n0 + n) * K + k0 + 8 * c) = o; }
    LDS_WAIT(); asm volatile("" ::: "memory");
}
__device__ __forceinline__ void rms_row2_to_bf16(const float* xrow0, const float* xrow1, const float* g, bf16* orow0, bf16* orow1, int lane) {
    const GAS f32x4* xa = (const GAS f32x4*)xrow0 + lane; const GAS f32x4* xb = (const GAS f32x4*)xrow1 + lane; const GAS f32x4* gr = (const GAS f32x4*)g + lane;
    f32x4 va[4], vb[4]; float sa = 0.f, sb = 0.f;
#pragma unroll
    for (int j = 0; j < 4; ++j) { va[j] = xa[64 * j]; vb[j] = xb[64 * j]; }
#pragma unroll
    for (int j = 0; j < 4; ++j) { sa += (va[j].x * va[j].x + va[j].y * va[j].y) + (va[j].z * va[j].z + va[j].w * va[j].w); sb += (vb[j].x * vb[j].x + vb[j].y * vb[j].y) + (vb[j].z * vb[j].z + vb[j].w * vb[j].w); }
    const float ra = rsqrtf(wave_sum(sa) * (1.f / 1024.f) + 1e-6f), rb = rsqrtf(wave_sum(sb) * (1.f / 1024.f) + 1e-6f);
    GAS unsigned long long* oa = (GAS unsigned long long*)orow0 + lane; GAS unsigned long long* ob = (GAS unsigned long long*)orow1 + lane;
#pragma unroll
    for (int j = 0; j < 4; ++j) { const f32x4 gg = gr[64 * j];
        oa[64 * j] = (unsigned long long)pk2(va[j].x * ra * gg.x, va[j].y * ra * gg.y) | ((unsigned long long)pk2(va[j].z * ra * gg.z, va[j].w * ra * gg.w) << 32);
        ob[64 * j] = (unsigned long long)pk2(vb[j].x * rb * gg.x, vb[j].y * rb * gg.y) | ((unsigned long long)pk2(vb[j].z * rb * gg.z, vb[j].w * rb * gg.w) << 32); }
}
__device__ __forceinline__ void rms_row_to_bf16(const float* xrow, const float* g, bf16* orow, int lane) {
    const GAS f32x4* xr = (const GAS f32x4*)xrow + lane; const GAS f32x4* gr = (const GAS f32x4*)g + lane;
    f32x4 v[4]; float s = 0.f;
#pragma unroll
    for (int j = 0; j < 4; ++j) { v[j] = xr[64 * j]; s += (v[j].x * v[j].x + v[j].y * v[j].y) + (v[j].z * v[j].z + v[j].w * v[j].w); }
    const float rstd = rsqrtf(wave_sum(s) * (1.f / 1024.f) + 1e-6f);
    GAS unsigned long long* o8 = (GAS unsigned long long*)orow + lane;
#pragma unroll
    for (int j = 0; j < 4; ++j) { const f32x4 gg = gr[64 * j];
        o8[64 * j] = (unsigned long long)pk2(v[j].x * rstd * gg.x, v[j].y * rstd * gg.y) | ((unsigned long long)pk2(v[j].z * rstd * gg.z, v[j].w * rstd * gg.w) << 32); }
}
__device__ __forceinline__ void p0_meta_item(LAS unsigned char* lds, int item, const float* meta, const float* g1, const float* w_in, bf16* KA, bf16* VA, float* KRM, float* VRM, unsigned* KN, int tid) {
    const int lane = tid & 63, wid = tid >> 6;
    LAS float* um = (LAS float*)lds;
    LAS float* part = (LAS float*)(lds + 65536);
    for (int rr = 0; rr < 2; ++rr) { const int r = wid * 2 + rr; const float* xrow = meta + r * 1024;
        f32x4 v[4]; float s = 0.f;
#pragma unroll
        for (int j = 0; j < 4; ++j) { v[j] = *((const f32x4*)xrow + lane + 64 * j); s += (v[j].x * v[j].x + v[j].y * v[j].y) + (v[j].z * v[j].z + v[j].w * v[j].w); }
        const float rstd = rsqrtf(wave_sum(s) * (1.f / 1024.f) + 1e-6f);
#pragma unroll
        for (int j = 0; j < 4; ++j) { const f32x4 gg = *((const f32x4*)g1 + lane + 64 * j); f32x4 o = v[j] * rstd * gg; *((LAS f32x4*)(um + r * 1024) + lane + 64 * j) = o; } }
    __syncthreads();
    const int j0 = item * 64 + lane;
    const int wcol = j0 < 2048 ? 1024 + j0 : 4096 + (j0 - 2048);
    float acc[16];
#pragma unroll
    for (int r = 0; r < 16; ++r) acc[r] = 0.f;
    const int kbeg = wid * 128;
    for (int k0 = kbeg; k0 < kbeg + 128; k0 += 16) {
        float wv[16];
#pragma unroll
        for (int q = 0; q < 16; ++q) wv[q] = w_in[(size_t)(k0 + q) * DIN + wcol];
#pragma unroll
        for (int q4 = 0; q4 < 4; ++q4)
#pragma unroll
            for (int r = 0; r < 16; ++r) { const f32x4 uu = *(const LAS f32x4*)(um + r * 1024 + k0 + 4 * q4); acc[r] += uu.x * wv[4 * q4] + uu.y * wv[4 * q4 + 1] + uu.z * wv[4 * q4 + 2] + uu.w * wv[4 * q4 + 3]; }
    }
#pragma unroll
    for (int r = 0; r < 16; ++r) part[(wid * 16 + r) * 64 + lane] = acc[r];
    __syncthreads();
    for (int o = tid; o < 1024; o += 512) { const int r = o >> 6, l = o & 63; float s = 0.f;
#pragma unroll
        for (int w = 0; w < 8; ++w) s += part[(w * 16 + r) * 64 + l];
        const int j = item * 64 + l;
        { float q8 = (j < 1024) ? s * s : 0.f; q8 += __shfl_xor(q8, 1); q8 += __shfl_xor(q8, 2); q8 += __shfl_xor(q8, 4);
          if (j < 1024 && (l & 7) == 0) for (int b = 0; b < BATCH; ++b) atomicMax(KN + ((b * 8 + (j >> 7)) * 2 + ((j >> 6) & 1)) * 8 + ((j >> 3) & 7), __float_as_uint(q8)); }
        if (j < 2048) { bf16* dst = j < 1024 ? KA : VA; const int col = j & 1023; const bf16 hv = (bf16)f2bf(s);
            for (int b = 0; b < BATCH; ++b) dst[((size_t)(b * 8 + (col >> 7)) * KVROWS + 48 + r) * 128 + (col & 127)] = hv; }
        else if (j < 3072) KRM[r * 1024 + (j - 2048)] = s * 0.0625f;
        else VRM[r * 2048 + (j - 3072)] = s; }
    __syncthreads();
}

namespace att {
typedef float f32x16 __attribute__((ext_vector_type(16)));
typedef short s16x4 __attribute__((ext_vector_type(4)));
typedef short v4i16_t __attribute__((ext_vector_type(4)));
constexpr int SLOT = 32768, OFF_QT = 3 * SLOT, OFF_WS = RING_BYTES + 1024, XSTR = 528;
static_assert(OFF_QT + 32768 <= RING_BYTES && 4 * 32 * XSTR <= 3 * SLOT && OFF_WS + 8 * 256 <= LDS_BYTES, "attention LDS map");
__device__ __forceinline__ int crow(int r, int hi) { return (r & 3) + 8 * (r >> 2) + 4 * hi; }
__device__ __forceinline__ s16x4 vtr(const LAS unsigned char* p) { return __builtin_bit_cast(s16x4, __builtin_amdgcn_ds_read_tr16_b64_v4i16((LAS v4i16_t*)p)); }
__device__ __forceinline__ float swapmax(float m) { auto rr = __builtin_amdgcn_permlane32_swap(__float_as_uint(m), __float_as_uint(m), false, false); return fmaxf(__uint_as_float(rr[0]), __uint_as_float(rr[1])); }
__device__ __forceinline__ float swapsum(float m) { auto rr = __builtin_amdgcn_permlane32_swap(__float_as_uint(m), __float_as_uint(m), false, false); return __uint_as_float(rr[0]) + __uint_as_float(rr[1]); }
__device__ __forceinline__ void dma16(const bf16* g, LAS unsigned char* l) { __builtin_amdgcn_global_load_lds((const unsigned*)g, (LAS unsigned*)l, 16, 0, 0); }
#define ATT_WAIT_BAR(N) asm volatile("s_waitcnt vmcnt(" #N ") lgkmcnt(0)\n\ts_barrier" ::: "memory")

__device__ __forceinline__ void attn_unit(LAS unsigned char* lds, int b, int h, int qblk, const bf16* QA, const bf16* KA, const bf16* VA, bf16* YDA, float lam, const float* headg, float slope2, const int tid, const unsigned* KN) {
    const int lane = tid & 63, r32 = lane & 31, hi = lane >> 5, wid = __builtin_amdgcn_readfirstlane(tid >> 6), c = wid & 1, qg = wid >> 1;
    const bf16* KAb = KA + (size_t)(b * 8 + h) * KVROWS * 128; const bf16* VAb = VA + (size_t)(b * 8 + h) * KVROWS * 128;
    const int drow = 8 * wid + (lane >> 4), dsl = lane & 15;
    unsigned koff[2], voff[2];
#pragma unroll
    for (int i = 0; i < 2; ++i) { const int row = drow + 4 * i; koff[i] = (unsigned)(row * 128 + ((dsl ^ (row & 15)) * 8)); voff[i] = (unsigned)(row * 128 + ((((dsl >> 2) ^ (row & 3)) * 4 + (dsl & 3)) * 8)); }
#define ATT_DMA(t, slot) do { const unsigned toff_ = (unsigned)((64 + 64 * (t)) * 128); LAS unsigned char* sb_ = lds + (slot) * SLOT + wid * 2048; \
        dma16(KAb + (koff[0] + toff_), sb_); dma16(KAb + (koff[1] + toff_), sb_ + 1024); dma16(VAb + (voff[0] + toff_), sb_ + 16384); dma16(VAb + (voff[1] + toff_), sb_ + 16384 + 1024); } while (0)
    const int q_idx = 128 * qblk + 32 * qg + r32;
    const int t_hi = 2 * qblk + 1;
    {
        const bf16* QAb = QA + (size_t)(b * SEQ + 128 * qblk) * 1024 + h * 128;
#pragma unroll
        for (int i = 0; i < 4; ++i) { const int row = 16 * wid + 4 * i + (lane >> 4); dma16(QAb + (unsigned)(row * 1024 + ((dsl ^ (row & 15)) * 8)), lds + OFF_QT + wid * 4096 + i * 1024); }
    }
    int s0 = 0, s1 = 1, s2 = 2;
    ATT_DMA(t_hi, 0); ATT_DMA(t_hi - 1, 1);
    const int A16 = ((c * 8 + hi) ^ (r32 & 15)) * 16;
    const LAS unsigned char* qfp = lds + OFF_QT + (32 * qg + r32) * 256;
    const int q4 = (lane & 15) >> 2;
    int kxo[4], vxo[4];
#pragma unroll
    for (int d0 = 0; d0 < 4; ++d0) { kxo[d0] = r32 * 256 + (A16 ^ (d0 * 32)); vxo[d0] = 16384 + (4 * hi + q4) * 256 + ((q4 ^ d0) * 64) + ((lane >> 4) & 1) * 32 + (lane & 3) * 8; }
    f32x16 base0;
#pragma unroll
    for (int r = 0; r < 16; ++r) base0[r] = slope2 * (float)crow(r, hi);
    const float s32 = 32.f * slope2;
    f32x16 o[4];
#pragma unroll
    for (int d = 0; d < 4; ++d)
#pragma unroll
        for (int r = 0; r < 16; ++r) o[d][r] = 0.f;
    float mref = -1e30f, l = 0.f;
    LAS float* wsf = (LAS float*)(lds + OFF_WS) + wid * 64;
    LAS unsigned char* votes = lds + OFF_WS + 2048 + 128;
    ATT_WAIT_BAR(4);
    float bq;
    { float kn2 = 0.f;
#pragma unroll
      for (int p = 0; p < 8; ++p) kn2 += __uint_as_float(KN[((b * 8 + h) * 2 + c) * 8 + p]);
      float q2 = 0.f;
#pragma unroll
      for (int d0 = 0; d0 < 4; ++d0) { const bf16x8 qv = *(const LAS bf16x8*)(qfp + (A16 ^ (d0 * 32)));
#pragma unroll
          for (int e = 0; e < 8; ++e) { const float f = __uint_as_float((unsigned)(unsigned short)qv[e] << 16); q2 += f * f; } }
      q2 = swapsum(q2);
      bq = sqrtf(q2 * kn2 * 1.02f) + 63.f * slope2 + 136.f; }
    bool wdone = false;
    for (int t = t_hi; t >= -1; --t) {
        if (t - 2 >= -1) ATT_DMA(t - 2, s2);
        if (!wdone && __all(bq + slope2 * 64.f * (float)(t - t_hi) < mref)) wdone = true;
        if (lane == 0) votes[(t & 1) * 8 + wid] = wdone ? 1 : 0;
        const bool active = !wdone && !(qg < 2 && t == t_hi);
        if (active) {
            const LAS unsigned char* sb = lds + s0 * SLOT;
            const LAS unsigned char* kp[4]; const LAS unsigned char* vp[4];
#pragma unroll
            for (int d0 = 0; d0 < 4; ++d0) { kp[d0] = sb + kxo[d0]; vp[d0] = sb + vxo[d0]; }
            bf16x8 kf[8], qf[4];
#pragma unroll
            for (int d0 = 0; d0 < 4; ++d0) { qf[d0] = *(const LAS bf16x8*)(qfp + (A16 ^ (d0 * 32))); kf[2 * d0] = *(const LAS bf16x8*)(kp[d0]); kf[2 * d0 + 1] = *(const LAS bf16x8*)(kp[d0] + 8192); }
            s16x4 vl[4], vh[4];
#define ATT_VLOAD(i, slot) do { vl[slot] = vtr(vp[(i) & 3] + ((i) >> 2) * 4096); vh[slot] = vtr(vp[(i) & 3] + ((i) >> 2) * 4096 + 2048); } while (0)
            __builtin_amdgcn_sched_barrier(0);
            f32x16 p0 = base0, p1 = base0;
#pragma unroll
            for (int d0 = 0; d0 < 4; ++d0) { p0 = __builtin_amdgcn_mfma_f32_32x32x16_bf16(kf[2 * d0], qf[d0], p0, 0, 0, 0); p1 = __builtin_amdgcn_mfma_f32_32x32x16_bf16(kf[2 * d0 + 1], qf[d0], p1, 0, 0, 0); }
            __builtin_amdgcn_sched_barrier(0);
            ATT_VLOAD(0, 0); ATT_VLOAD(1, 1); ATT_VLOAD(2, 2); ATT_VLOAD(3, 3);
            __builtin_amdgcn_sched_barrier(0);
            if (t == -1 || 64 * t + 63 > 128 * qblk + 32 * qg) {
                const int kv0 = 64 * t + 4 * hi;
#pragma unroll
                for (int r = 0; r < 16; ++r) { const int kv = kv0 + (r & 3) + 8 * (r >> 2);
                    const bool v0 = (kv <= q_idx) && (t >= 0 || kv >= -16), v1 = (kv + 32 <= q_idx) && (t >= 0 || kv + 32 >= -16);
                    p0[r] = v0 ? p0[r] : -INFINITY; p1[r] = v1 ? p1[r] : -INFINITY; }
            }
            const float toffs = slope2 * 64.f * (float)(t - t_hi);
            float pm = p0[0], pm1 = p1[0];
#pragma unroll
            for (int r = 1; r < 16; ++r) { pm = fmaxf(pm, p0[r]); pm1 = fmaxf(pm1, p1[r]); }
            pm = swapmax(fmaxf(pm, pm1 + s32));
            const float cand = pm + toffs;
            if (__any(cand > mref + 8.0f)) {
                const float mnew = fmaxf(mref, cand), f = __builtin_amdgcn_exp2f(mref - mnew); l *= f; mref = mnew;
                if (hi == 0) wsf[r32] = f;
                float fr[16];
#pragma unroll
                for (int r = 0; r < 16; ++r) fr[r] = wsf[crow(r, hi)];
#pragma unroll
                for (int d = 0; d < 4; ++d)
#pragma unroll
                    for (int r = 0; r < 16; ++r) o[d][r] *= fr[r];
            }
            const float mrel = mref - toffs, mrel1 = mrel - s32;
            float sacc = 0.f;
#pragma unroll
            for (int r = 0; r < 16; ++r) { p0[r] = __builtin_amdgcn_exp2f(p0[r] - mrel); p1[r] = __builtin_amdgcn_exp2f(p1[r] - mrel1); sacc += p0[r] + p1[r]; }
            l += sacc;
            v4u pw[4];
#pragma unroll
            for (int q = 0; q < 4; ++q) { pw[0][q] = pg8::cvt_pk_bf16(p0[2 * q], p0[2 * q + 1]); pw[1][q] = pg8::cvt_pk_bf16(p0[8 + 2 * q], p0[9 + 2 * q]);
                pw[2][q] = pg8::cvt_pk_bf16(p1[2 * q], p1[2 * q + 1]); pw[3][q] = pg8::cvt_pk_bf16(p1[8 + 2 * q], p1[9 + 2 * q]); }
            __builtin_amdgcn_sched_barrier(0);
#pragma unroll
            for (int i = 0; i < 16; ++i) { const bf16x8 vf = (bf16x8){vl[i & 3][0], vl[i & 3][1], vl[i & 3][2], vl[i & 3][3], vh[i & 3][0], vh[i & 3][1], vh[i & 3][2], vh[i & 3][3]};
                o[i & 3] = __builtin_amdgcn_mfma_f32_32x32x16_bf16(__builtin_bit_cast(bf16x8, pw[i >> 2]), vf, o[i & 3], 0, 0, 0);
                if (i + 4 < 16) ATT_VLOAD(i + 4, i & 3);
                __builtin_amdgcn_sched_barrier(0); }
#undef ATT_VLOAD
        }
        if (t - 2 >= -1) ATT_WAIT_BAR(4); else ATT_WAIT_BAR(0);
        { const int tmp = s0; s0 = s1; s1 = s2; s2 = tmp; }
        { const unsigned v0 = *(const LAS unsigned*)(votes + (t & 1) * 8), v1 = *(const LAS unsigned*)(votes + (t & 1) * 8 + 4); if (v0 == 0x01010101u && v1 == 0x01010101u) break; }
    }
    ATT_WAIT_BAR(0);
#undef ATT_DMA
    l = swapsum(l);
    if (hi == 0) wsf[32 + r32] = l;
    float rli[16];
#pragma unroll
    for (int r = 0; r < 16; ++r) rli[r] = 1.0f / wsf[32 + crow(r, hi)];
#pragma unroll
    for (int d = 0; d < 4; ++d)
#pragma unroll
        for (int r = 0; r < 16; ++r) o[d][r] *= rli[r];
    LAS unsigned char* xb = lds + qg * 32 * XSTR;
    if (c == 1) {
#pragma unroll
        for (int d = 0; d < 4; ++d)
#pragma unroll
            for (int r = 0; r < 16; ++r) *(LAS float*)(xb + crow(r, hi) * XSTR + (32 * d + r32) * 4) = o[d][r];
    }
    __syncthreads();
    if (c == 0) {
#pragma unroll
        for (int d = 0; d < 4; ++d)
#pragma unroll
            for (int r = 0; r < 16; ++r) { LAS float* p = (LAS float*)(xb + crow(r, hi) * XSTR + (32 * d + r32) * 4); *p = o[d][r] - lam * *p; }
        asm volatile("s_waitcnt lgkmcnt(0)" ::: "memory");
        int le = lane; asm volatile("" : "+v"(le));
        const int row = le >> 1, ch = le & 1;
        const LAS pg8::f32x4* rp = (const LAS pg8::f32x4*)(xb + row * XSTR + ch * 256);
        pg8::f32x4 v[16]; float ss = 0.f;
#pragma unroll
        for (int j = 0; j < 16; ++j) { v[j] = rp[j]; ss += (v[j][0] * v[j][0] + v[j][1] * v[j][1]) + (v[j][2] * v[j][2] + v[j][3] * v[j][3]); }
        ss += __shfl_xor(ss, 1);
        const float sc = rsqrtf(ss * (1.0f / 128.0f) + 1e-6f) * 0.8f;
        const pg8::f32x4* gp = (const pg8::f32x4*)(headg + (unsigned)(ch * 64));
        bf16* yp = YDA + (size_t)(b * SEQ + 128 * qblk + 32 * qg) * 1024 + h * 128 + (unsigned)(row * 1024 + ch * 64);
#pragma unroll
        for (int j = 0; j < 8; ++j) { const pg8::f32x4 g0 = gp[2 * j], g1 = gp[2 * j + 1]; *(v4u*)(yp + 8 * j) = pg8::pack8(v[2 * j] * g0 * sc, v[2 * j + 1] * g1 * sc); }
    }
    __syncthreads();
}
}

namespace ret {
using att::f32x16; using att::s16x4; using att::vtr; using att::crow;
constexpr int QSTR = 272, VPSTR = 144, STSTR = 528;
constexpr int OFF_Q = 0, OFF_KH = 128 * QSTR, OFF_VP = 2 * 128 * QSTR, OFF_ST = OFF_VP + 128 * VPSTR, LDS_END = OFF_ST + 64 * STSTR;
static_assert(LDS_END <= RING_BYTES, "retention LDS map");

template <int HF>
__device__ __forceinline__ void compute_half(LAS unsigned char* lds, int wid, int lane, f32x16& X0, f32x16& X1, f32x16& Cacc, f32x16& S, float g128) {
    const int r32 = lane & 31, hi = lane >> 5;
    { const int kb = wid & 3, qbp = wid >> 2; const bool need0 = kb <= 2 * qbp, need1 = kb <= 2 * qbp + 1;
      if (need1) {
        const LAS unsigned char* kp = lds + OFF_KH + (32 * kb + r32) * QSTR + hi * 16;
        const LAS unsigned char* q0 = lds + OFF_Q + (64 * qbp + r32) * QSTR + hi * 16;
#pragma unroll
        for (int ks = 0; ks < 8; ++ks) { const bf16x8 ka = *(const LAS bf16x8*)(kp + ks * 32);
            if (need0) { const bf16x8 qf = *(const LAS bf16x8*)(q0 + ks * 32); X0 = __builtin_amdgcn_mfma_f32_32x32x16_bf16(ka, qf, X0, 0, 0, 0); }
            const bf16x8 qf1 = *(const LAS bf16x8*)(q0 + 32 * QSTR + ks * 32); X1 = __builtin_amdgcn_mfma_f32_32x32x16_bf16(ka, qf1, X1, 0, 0, 0); }
      } }
    const int qb = wid >> 1, eb = wid & 1;
    { const LAS unsigned char* qp = lds + OFF_Q + (32 * qb + r32) * QSTR + hi * 16;
      const LAS unsigned char* sp = lds + OFF_ST + (32 * eb + r32) * STSTR + HF * 256 + hi * 16;
#pragma unroll
      for (int ks = 0; ks < 8; ++ks) { const bf16x8 qa = *(const LAS bf16x8*)(qp + ks * 32), sb = *(const LAS bf16x8*)(sp + ks * 32);
          Cacc = __builtin_amdgcn_mfma_f32_32x32x16_bf16(qa, sb, Cacc, 0, 0, 0); } }
    { const int dkl = wid >> 1, q4 = (lane & 15) >> 2, g1 = (lane >> 4) & 1, p = lane & 3;
#pragma unroll
      for (int r = 0; r < 16; ++r) S[r] *= g128;
      const LAS unsigned char* kt = lds + OFF_KH + (4 * q4 + 2 * hi) * QSTR + (32 * dkl + 16 * g1 + 4 * p) * 2;
      const LAS unsigned char* vt = lds + OFF_VP + (4 * q4 + 2 * hi) * VPSTR + (32 * eb + 16 * g1 + 4 * p) * 2;
#pragma unroll
      for (int ks = 0; ks < 8; ++ks) { const s16x4 a0 = vtr(kt + ks * 16 * QSTR), a1 = vtr(kt + ks * 16 * QSTR + QSTR), b0 = vtr(vt + ks * 16 * VPSTR), b1 = vtr(vt + ks * 16 * VPSTR + VPSTR);
          const bf16x8 af = (bf16x8){a0[0], a0[1], a0[2], a0[3], a1[0], a1[1], a1[2], a1[3]}, bfr = (bf16x8){b0[0], b0[1], b0[2], b0[3], b1[0], b1[1], b1[2], b1[3]};
          S = __builtin_amdgcn_mfma_f32_32x32x16_bf16(af, bfr, S, 0, 0, 0); } }
}
__device__ __forceinline__ void write_st(LAS unsigned char* lds, int dkb, int eb, int lane, const f32x16& S) {
    const int r32 = lane & 31, hi = lane >> 5; LAS unsigned char* p = lds + OFF_ST + (32 * eb + r32) * STSTR + (32 * dkb + 4 * hi) * 2;
#pragma unroll
    for (int g = 0; g < 4; ++g) { u32x2 w; w.x = pg8::cvt_pk_bf16(S[4 * g], S[4 * g + 1]); w.y = pg8::cvt_pk_bf16(S[4 * g + 2], S[4 * g + 3]); *(LAS u32x2*)(p + g * 16) = w; }
}
__device__ __forceinline__ void write_a(LAS unsigned char* lds, int kb, int qb, int lane, const f32x16& X) {
    const int r32 = lane & 31, hi = lane >> 5, q = 32 * qb + r32; LAS unsigned char* p = lds + OFF_Q + q * QSTR + (32 * kb + 4 * hi) * 2;
#pragma unroll
    for (int g = 0; g < 4; ++g) { const int k = 32 * kb + 8 * g + 4 * hi; float v[4];
#pragma unroll
        for (int j = 0; j < 4; ++j) v[j] = (k + j <= q) ? X[4 * g + j] : 0.f;
        u32x2 w; w.x = pg8::cvt_pk_bf16(v[0], v[1]); w.y = pg8::cvt_pk_bf16(v[2], v[3]); *(LAS u32x2*)(p + g * 16) = w; }
}

__device__ __forceinline__ void ret_item(LAS unsigned char* lds, int b, int h, int sl, const bf16* QR, const bf16* KR, bf16* VR, const float* KRM, const float* VRM, float* SS, const int tid) {
    const int lane = tid & 63, r32 = lane & 31, hi = lane >> 5, wid = __builtin_amdgcn_readfirstlane(tid >> 6);
    const float lg = log2f(1.0f - exp2f(-5.0f - (float)h));
    const float g128 = exp2f(128.f * lg);
    const int qb = wid >> 1, eb = wid & 1, dkl = wid >> 1;
    f32x16 S0, S1;
#pragma unroll
    for (int r = 0; r < 16; ++r) { S0[r] = 0.f; S1[r] = 0.f; }
    for (int m = 0; m < NMETA; ++m) { const float dm = exp2f(lg * (float)(15 - m)), vv = VRM[m * 2048 + h * 512 + sl * 64 + 32 * eb + r32] * dm; const float* kr = KRM + m * 1024 + h * 256 + 32 * dkl;
#pragma unroll
        for (int r = 0; r < 16; ++r) { S0[r] += kr[crow(r, hi)] * vv; S1[r] += kr[128 + crow(r, hi)] * vv; } }
    write_st(lds, dkl, eb, lane, S0); write_st(lds, 4 + dkl, eb, lane, S1);
    const int srow = tid >> 4, sch = tid & 15;
    const int vrow = tid >> 3, vch = tid & 7;
    const size_t rowb = (size_t)b * SEQ;
    const bf16* qsrc = QR + (rowb + srow) * 1024 + h * 256 + sch * 8;
    const bf16* ksrc = KR + (rowb + srow) * 1024 + h * 256 + sch * 8;
    bf16* vsrc = VR + (rowb + vrow) * 2048 + h * 512 + sl * 64 + vch * 8;
    LAS unsigned char* qdst = lds + OFF_Q + srow * QSTR + sch * 16;
    LAS unsigned char* kdst = lds + OFF_KH + srow * QSTR + sch * 16;
    LAS unsigned char* vdst = lds + OFF_VP + vrow * VPSTR + vch * 16;
    float vsc[2];
#pragma unroll
    for (int i = 0; i < 2; ++i) vsc[i] = exp2f(lg * (float)(127 - (vrow + 64 * i)));
    v4u qreg[4], kreg[4], vreg[2];
#pragma unroll
    for (int i = 0; i < 4; ++i) { qreg[i] = *(const v4u*)(qsrc + (size_t)i * 32 * 1024); kreg[i] = *(const v4u*)(ksrc + (size_t)i * 32 * 1024); }
#pragma unroll
    for (int i = 0; i < 2; ++i) vreg[i] = *(const v4u*)(vsrc + (size_t)i * 64 * 2048);
    f32x16 X0, X1, Cacc, T;
#pragma unroll
    for (int r = 0; r < 16; ++r) { X0[r] = 0.f; X1[r] = 0.f; Cacc[r] = 0.f; T[r] = 0.f; }
    for (int c = 0; c < 32; ++c) {
        const size_t coff = (size_t)c * 128;
#pragma unroll
        for (int i = 0; i < 4; ++i) { *(LAS v4u*)(qdst + i * 32 * QSTR) = qreg[i]; *(LAS v4u*)(kdst + i * 32 * QSTR) = kreg[i]; }
#pragma unroll
        for (int i = 0; i < 2; ++i) { pg8::f32x4 a, bq; pg8::unpack8(vreg[i], a, bq); *(LAS v4u*)(vdst + i * 64 * VPSTR) = pg8::pack8(a * vsc[i], bq * vsc[i]); }
#pragma unroll
        for (int i = 0; i < 4; ++i) { qreg[i] = *(const v4u*)(qsrc + (coff + i * 32) * 1024 + 128); kreg[i] = *(const v4u*)(ksrc + (coff + i * 32) * 1024 + 128); }
        __syncthreads();
        compute_half<0>(lds, wid, lane, X0, X1, Cacc, S0, g128);
        __syncthreads();
#pragma unroll
        for (int i = 0; i < 4; ++i) { *(LAS v4u*)(qdst + i * 32 * QSTR) = qreg[i]; *(LAS v4u*)(kdst + i * 32 * QSTR) = kreg[i]; }
        write_st(lds, dkl, eb, lane, S0);
        if (c + 1 < 32) {
#pragma unroll
            for (int i = 0; i < 4; ++i) { qreg[i] = *(const v4u*)(qsrc + (coff + 128 + i * 32) * 1024); kreg[i] = *(const v4u*)(ksrc + (coff + 128 + i * 32) * 1024); }
#pragma unroll
            for (int i = 0; i < 2; ++i) vreg[i] = *(const v4u*)(vsrc + (coff + 128 + i * 64) * 2048);
        }
        __syncthreads();
        compute_half<1>(lds, wid, lane, X0, X1, Cacc, S1, g128);
        __syncthreads();
        write_st(lds, 4 + dkl, eb, lane, S1);
        { const int kb = wid & 3, qbp = wid >> 2;
          if (kb <= 2 * qbp) write_a(lds, kb, 2 * qbp, lane, X0);
          if (kb <= 2 * qbp + 1) write_a(lds, kb, 2 * qbp + 1, lane, X1); }
        __syncthreads();
        { const int q4 = (lane & 15) >> 2, g1 = (lane >> 4) & 1, p = lane & 3;
          const LAS unsigned char* ap = lds + OFF_Q + (32 * qb + r32) * QSTR + hi * 16;
          const LAS unsigned char* vp = lds + OFF_VP + (8 * hi + q4) * VPSTR + (32 * eb + 16 * g1 + 4 * p) * 2;
#pragma unroll
          for (int kb = 0; kb < 4; ++kb) if (kb <= qb) {
#pragma unroll
              for (int s = 0; s < 2; ++s) { const bf16x8 af = *(const LAS bf16x8*)(ap + (32 * kb + 16 * s) * 2);
                  const s16x4 lo = vtr(vp + (32 * kb + 16 * s) * VPSTR), hh = vtr(vp + (32 * kb + 16 * s + 4) * VPSTR);
                  const bf16x8 vf = (bf16x8){lo[0], lo[1], lo[2], lo[3], hh[0], hh[1], hh[2], hh[3]};
                  T = __builtin_amdgcn_mfma_f32_32x32x16_bf16(af, vf, T, 0, 0, 0); } }
          bf16* op = VR + (rowb + coff + 32 * qb) * 2048 + h * 512 + sl * 64 + 32 * eb + r32;
          float* ssp = SS + (rowb + coff + 32 * qb) * 64 + h * 16 + sl * 2 + eb;
          float lgc = lg; asm volatile("" : "+v"(lgc));
#pragma unroll
          for (int r = 0; r < 16; ++r) { const float qf = (float)(32 * qb + crow(r, hi)); const float v = __builtin_amdgcn_exp2f(lgc * (qf - 127.f)) * T[r] + __builtin_amdgcn_exp2f(lgc * (qf + 1.f)) * Cacc[r]; op[(size_t)crow(r, hi) * 2048] = (bf16)f2bf(v);
              float s = v * v; s += __shfl_xor(s, 1); s += __shfl_xor(s, 2); s += __shfl_xor(s, 4); s += __shfl_xor(s, 8); s += __shfl_xor(s, 16);
              if (r32 == 0) ssp[(size_t)crow(r, hi) * 64] = s; }
#pragma unroll
          for (int r = 0; r < 16; ++r) { X0[r] = 0.f; X1[r] = 0.f; Cacc[r] = 0.f; T[r] = 0.f; } }
        __syncthreads();
    }
}
}

#ifndef MK_N_LAUNCHES
#define MK_N_LAUNCHES 1
#endif
constexpr int NPH = 11;
struct Args { const float* in[16]; float* out; unsigned char* ws; int ph_lo, ph_hi, dry, pad; };
__global__ void __launch_bounds__(NWAVES * 64, 2) fwd(Args args) {
    extern __shared__ __attribute__((aligned(16))) unsigned char lds_raw[];
    LAS unsigned char* lds = (LAS unsigned char*)lds_raw;
    volatile LAS unsigned* MISC = (volatile LAS unsigned*)(lds + MISC_OFF);
    const int wave = __builtin_amdgcn_readfirstlane(threadIdx.x >> 6);
#define PHASE_TID const int tid = threadIdx.x; int lane = tid; asm volatile("" : "+v"(lane)); lane &= 63; (void)lane;
    const int G = gridDim.x, bx = blockIdx.x, vcu = (G % 8 == 0) ? (bx % 8) * (G / 8) + bx / 8 : bx;
    typedef __attribute__((address_space(4))) const unsigned char* karg_t;
    karg_t kp0 = (karg_t)__builtin_amdgcn_kernarg_segment_ptr();
#define KARG_IN(i) (*(const float* __attribute__((address_space(4))) const*)(kp + 8 * (i)))
#define PHASE_PTRS \
    karg_t kp = kp0; asm volatile("" : "+s"(kp)); \
    float* out = *(float* __attribute__((address_space(4))) const*)(kp + 128); unsigned char* ws = *(unsigned char* __attribute__((address_space(4))) const*)(kp + 136); \
    bf16* QA = (bf16*)out; (void)QA; (void)ws; PHASE_TID
    gu32* ctl = (gu32*)(args.ws + WS_CTL);
    for (int u = threadIdx.x; u < (LDS_BYTES - LDSCTL_OFF) / 4; u += NWAVES * 64) ((LAS unsigned*)(lds + LDSCTL_OFF))[u] = 0u;
    __syncthreads();
    const int lo = args.ph_lo, hi = args.ph_hi;
    XcdBarrier bar; bar.bar = (unsigned*)(ctl + CW_BAR); bar.x = 0; bar.st = nullptr;
    if (hi - lo > 1) bar = xcd_barrier_post((unsigned*)(ctl + CW_BAR), MISC + 8);
#ifdef ONLY_PHASE
#define IN(k) ((k) == ONLY_PHASE && lo <= (k) && (k) < hi)
#else
#define IN(k) (lo <= (k) && (k) < hi)
#endif
#define SEAM(k) do { if (IN(k) && IN((k) + 1)) xcd_barrier(bar); } while (0)

    if (IN(0)) { PHASE_PTRS
        const float* x = KARG_IN(0); const float* meta = KARG_IN(1); const float* g1 = KARG_IN(2); const float* w_in = KARG_IN(3);
        const float* w_pa = KARG_IN(9); const float* w_pr = KARG_IN(10); const float* w_out = KARG_IN(11); const float* g2 = KARG_IN(12); const float* w_up = KARG_IN(13); const float* w_dn = KARG_IN(14);
        bf16* Win_t = (bf16*)(ws + WS_WIN); bf16* Wpa_t = (bf16*)(ws + WS_WPA); bf16* Wpr_t = (bf16*)(ws + WS_WPR); bf16* Wout_t = (bf16*)(ws + WS_WOUT); bf16* Wup_t = (bf16*)(ws + WS_WUP); bf16* Wdn_t = (bf16*)(ws + WS_WDN);
        bf16* U = (bf16*)(ws + WS_U); bf16* KA = (bf16*)(ws + WS_KA); bf16* VA = (bf16*)(ws + WS_VA); float* KRM = (float*)(ws + WS_KRM); float* VRM = (float*)(ws + WS_VRM);
        if (bx < 80) p0_meta_item(lds, bx, meta, g1, w_in, KA, VA, KRM, VRM, (unsigned*)(ws + WS_CTL) + CW_KN, tid);
        {
            const int gt = bx * 512 + tid;
            for (int i = gt; i < 2 * BATCH * 8 * 48 * 16; i += G * 512) { const int arr = i / (BATCH * 8 * 48 * 16), rem = i % (BATCH * 8 * 48 * 16), bh = rem / (48 * 16), r2 = rem % (48 * 16);
                bf16* dst = (arr ? VA : KA) + (size_t)bh * KVROWS * 128 + (size_t)r2 * 8; *(v4u*)dst = (v4u){0u, 0u, 0u, 0u}; } }
        LAS float* scr = (LAS float*)(lds + wave * 16384);
        const int gw = vcu * NWAVES + wave, NGW = G * NWAVES;
        constexpr int I_IN = 16 * (DIN / 32), I_PA = 16 * 32, I_PR = 32 * 32, I_OUT = 16 * 32, I_UP = 16 * (DFF / 32), I_DN = 64 * 32;
        constexpr int NITEMS = I_IN + I_PA + I_PR + I_OUT + I_UP + I_DN;
        for (int it = gw; it < NITEMS; it += NGW) {
            int r = it;
            if (r < I_IN) { p0_transpose_item(w_in, 1024, DIN, Win_t, nullptr, scr, r, lane); continue; } r -= I_IN;
            if (r < I_PA) { p0_transpose_item(w_pa, 1024, 1024, Wpa_t, nullptr, scr, r, lane); continue; } r -= I_PA;
            if (r < I_PR) { p0_transpose_item(w_pr, 2048, 1024, Wpr_t, nullptr, scr, r, lane); continue; } r -= I_PR;
            if (r < I_OUT) { p0_transpose_item(w_out, 1024, 1024, Wout_t, nullptr, scr, r, lane); continue; } r -= I_OUT;
            if (r < I_UP) { p0_transpose_item(w_up, 1024, DFF, Wup_t, g2, scr, r, lane); continue; } r -= I_UP;
            p0_transpose_item(w_dn, DFF, 1024, Wdn_t, nullptr, scr, r, lane);
        }
        for (int m = gw; m < MR; m += 2 * NGW) { const int m1 = m + NGW;
            if (m1 < MR) rms_row2_to_bf16(x + (size_t)m * 1024, x + (size_t)m1 * 1024, g1, U + (size_t)m * 1024, U + (size_t)m1 * 1024, lane);
            else rms_row_to_bf16(x + (size_t)m * 1024, g1, U + (size_t)m * 1024, lane); }
    }
    SEAM(0);
    if (IN(1)) { PHASE_PTRS bf16* U = (bf16*)(ws + WS_U); bf16* Win_t = (bf16*)(ws + WS_WIN);
        pg8::Gemm g{U, Win_t, MR, NQKV, 1024}; pg8::StaticOrder S; S.init(MR, NQKV, G, bx); pg8::EpiQKV E{QA, ws};
        pg8::gemm_phase<pg8::EpiQKV, pg8::StaticOrder, true, true>(lds, g, S, E, tid); }
    SEAM(1);
    if (IN(2)) { PHASE_PTRS bf16* KA = (bf16*)(ws + WS_KA); bf16* VA = (bf16*)(ws + WS_VA);
        float lam;
        { const float* lq1 = KARG_IN(4); const float* lk1 = KARG_IN(5); const float* lq2 = KARG_IN(6); const float* lk2 = KARG_IN(7); float s1 = 0.f, s2 = 0.f;
          for (int i = 0; i < 64; ++i) { s1 += lq1[i] * lk1[i]; s2 += lq2[i] * lk2[i]; }
          lam = expf(s1) - expf(s2) + 0.2f; }
        const float* headg = KARG_IN(8);
        const unsigned x0 = xb_xcc_id() & 7u;
        for (unsigned dx = 0; dx < 8; ++dx) { const unsigned xq = (x0 + dx) & 7u; gu32* qw = ctl + CW_QUEUE + 64 * xq;
            for (;;) {
                if (tid == 0) MISC[16] = __hip_atomic_fetch_add(qw, 1u, RLX_AGENT);
                __syncthreads();
                const unsigned u = MISC[16];
                if (u >= 256u) break;
                const int bh = (int)(xq * 8u + (u >> 5)), qblk = 31 - (int)(u & 31u), b = bh >> 3, h = bh & 7;
                const float slope2 = exp2f(-(float)(h + 1)) * 1.4426950408889634f;
                bf16* YD = QA + (args.dry ? (size_t)MR * 1024 : (size_t)0);
                att::attn_unit(lds, b, h, qblk, QA, KA, VA, YD, lam, headg, slope2, tid, (const unsigned*)(ws + WS_CTL) + CW_KN);
            }
            __syncthreads();
        }
    }
    if (IN(3)) { PHASE_PTRS bf16* QR = (bf16*)(ws + WS_QR); bf16* KR = (bf16*)(ws + WS_KR); bf16* VR = (bf16*)(ws + WS_VR); float* KRM = (float*)(ws + WS_KRM); float* VRM = (float*)(ws + WS_VRM); float* SS = (float*)(ws + WS_SS);
        for (int it = vcu; it < 256; it += G) ret::ret_item(lds, it >> 5, (it >> 3) & 3, it & 7, QR, KR, VR, KRM, VRM, SS, tid); }
    SEAM(3);
    if (IN(4)) { PHASE_PTRS bf16* U = (bf16*)(ws + WS_U); bf16* Win_t = (bf16*)(ws + WS_WIN); float* SS = (float*)(ws + WS_SS);
        pg8::Gemm g{U, Win_t + (size_t)NQKV * 1024, MR, NGATE, 1024}; pg8::StaticOrder S; S.init(MR, NGATE, G, bx); pg8::EpiGates E{ws, SS};
        pg8::gemm_phase<pg8::EpiGates, pg8::StaticOrder, true, true>(lds, g, S, E, tid); }
    SEAM(4);
    if (IN(5)) { PHASE_PTRS bf16* Wpa_t = (bf16*)(ws + WS_WPA); bf16* SGA = (bf16*)(ws + WS_SGA); bf16* TMP = (bf16*)(ws + WS_TMP);
        pg8::Gemm g{QA, Wpa_t, MR, 1024, 1024}; pg8::StaticOrder S; S.init(MR, 1024, G, bx); pg8::EpiMergeA E{SGA, TMP};
        pg8::gemm_phase<pg8::EpiMergeA, pg8::StaticOrder, true, true>(lds, g, S, E, tid); }
    if (IN(6)) { PHASE_PTRS bf16* VR = (bf16*)(ws + WS_VR); bf16* Wpr_t = (bf16*)(ws + WS_WPR); bf16* SGR = (bf16*)(ws + WS_SGR); bf16* TMP = (bf16*)(ws + WS_TMP); bf16* MRG = (bf16*)(ws + WS_MRG);
        pg8::Gemm g{VR, Wpr_t, MR, 1024, 2048}; pg8::StaticOrder S; S.init(MR, 1024, G, bx); pg8::EpiMergeB E{SGR, TMP, MRG};
        pg8::gemm_phase<pg8::EpiMergeB, pg8::StaticOrder, true, true>(lds, g, S, E, tid); }
    SEAM(6);
    if (IN(7)) { PHASE_PTRS const float* x = KARG_IN(0); bf16* MRG = (bf16*)(ws + WS_MRG); bf16* Wout_t = (bf16*)(ws + WS_WOUT); bf16* H1B = (bf16*)(ws + WS_H1B); float* SS2 = (float*)(ws + WS_SS2);
        pg8::Gemm g{MRG, Wout_t, MR, 1024, 1024}; pg8::StaticOrder S; S.init(MR, 1024, G, bx); pg8::EpiOut E{x, out, H1B, SS2};
        pg8::gemm_phase<pg8::EpiOut, pg8::StaticOrder, true, true>(lds, g, S, E, tid); }
    SEAM(7);
    if (IN(8)) { PHASE_PTRS bf16* H1B = (bf16*)(ws + WS_H1B); bf16* Wup_t = (bf16*)(ws + WS_WUP); float* SS2 = (float*)(ws + WS_SS2); bf16* HID = (bf16*)(ws + WS_HID);
        pg8::Gemm g{H1B, Wup_t, MR, DFF, 1024}; pg8::StaticOrder S; S.init(MR, DFF, G, bx); pg8::EpiUp E{SS2, HID};
        pg8::gemm_phase<pg8::EpiUp, pg8::StaticOrder, true, true>(lds, g, S, E, tid); }
    SEAM(8);
    if (IN(9)) { PHASE_PTRS bf16* HID = (bf16*)(ws + WS_HID); bf16* Wdn_t = (bf16*)(ws + WS_WDN);
        pg8::Gemm g{HID, Wdn_t, MR, 1024, DFF}; pg8::StaticOrder S; S.init(MR, 1024, G, bx); pg8::EpiDown E{out};
        pg8::gemm_phase<pg8::EpiDown, pg8::StaticOrder, true, true>(lds, g, S, E, tid); }
    SEAM(9);
    if (IN(10)) { PHASE_PTRS const float* gf = KARG_IN(15); const int gw = vcu * NWAVES + wave, NGW = G * NWAVES;
        const GAS f32x4* gr = (const GAS f32x4*)gf + lane;
        for (int m = gw; m < MR; m += 2 * NGW) { const int m1 = (m + NGW < MR) ? m + NGW : m;
            GAS f32x4* xa = (GAS f32x4*)(out + (size_t)m * 1024) + lane; GAS f32x4* xb = (GAS f32x4*)(out + (size_t)m1 * 1024) + lane;
            f32x4 va[4], vb[4]; float sa = 0.f, sb = 0.f;
#pragma unroll
            for (int j = 0; j < 4; ++j) { va[j] = xa[64 * j]; vb[j] = xb[64 * j]; }
#pragma unroll
            for (int j = 0; j < 4; ++j) { sa += (va[j].x * va[j].x + va[j].y * va[j].y) + (va[j].z * va[j].z + va[j].w * va[j].w); sb += (vb[j].x * vb[j].x + vb[j].y * vb[j].y) + (vb[j].z * vb[j].z + vb[j].w * vb[j].w); }
            const float ra = rsqrtf(wave_sum(sa) * (1.f / 1024.f) + 1e-6f), rb = rsqrtf(wave_sum(sb) * (1.f / 1024.f) + 1e-6f);
#pragma unroll
            for (int j = 0; j < 4; ++j) { const f32x4 gg = gr[64 * j]; xa[64 * j] = va[j] * ra * gg; if (m1 != m) xb[64 * j] = vb[j] * rb * gg; } } }
#undef IN
#undef SEAM
}

extern "C" void kernel_launch(void* const* d_in, const int* in_sizes, int n_in, void* d_out, int out_size, void* d_ws, size_t ws_size, hipStream_t stream) {
    static int grid = 0;
    if (grid == 0) {
        if (n_in != 16 || in_sizes[0] != MR * 1024 || out_size != MR * 1024 || ws_size < WS_END) { fprintf(stderr, "kernel_launch: unexpected shapes / workspace (n_in %d, in0 %d, out %d, ws %zu); nothing launched\n", n_in, n_in > 0 ? in_sizes[0] : -1, out_size, ws_size); grid = -1; return; }
        int dev = 0, cus = 0;
        if (hipGetDevice(&dev) != hipSuccess || hipDeviceGetAttribute(&cus, hipDeviceAttributeMultiprocessorCount, dev) != hipSuccess) { grid = -1; return; }
        if (hipFuncSetAttribute((const void*)fwd, hipFuncAttributeMaxDynamicSharedMemorySize, LDS_BYTES) != hipSuccess) { fprintf(stderr, "kernel_launch: hipFuncSetAttribute failed\n"); grid = -1; return; }
        (void)hipGetLastError();
        grid = cus;
    }
    if (grid < 0) return;
    (void)hipMemsetAsync((char*)d_ws + WS_CTL, 0, CTL_ZERO_BYTES, stream);
    Args a{};
    for (int i = 0; i < 16; ++i) a.in[i] = (const float*)d_in[i];
    a.out = (float*)d_out; a.ws = (unsigned char*)d_ws;
#if MK_N_LAUNCHES == 1
    a.ph_lo = 0; a.ph_hi = NPH; hipLaunchKernelGGL(fwd, dim3(grid), dim3(NWAVES * 64), LDS_BYTES, stream, a);
#else
    for (int ph = 0; ph < NPH; ++ph) { a.ph_lo = ph; a.ph_hi = ph + 1;
#if defined(PROBE_MASK)
        if ((PROBE_MASK >> ph) & 1) { a.dry = 1; hipLaunchKernelGGL(fwd, dim3(grid), dim3(NWAVES * 64), LDS_BYTES, stream, a); a.dry = 0; }
#endif
        hipLaunchKernelGGL(fwd, dim3(grid), dim3(NWAVES * 64), LDS_BYTES, stream, a); }
#endif
}
```
